# Optimizing an MI355X kernel written in HIP

```python
import jax, jax.numpy as jnp
from jax import lax
import numpy as np

D_MODEL = 1024
BATCH = 4
SEQ = 4096
DEPTH = 1

MIX_WIDTH = D_MODEL
CONV_WIDTH = MIX_WIDTH // 2
CONV_GROUPS = 8
CONV_K = 3
MLSTM_HEADS = 4
MLSTM_V_DIM = (MIX_WIDTH - CONV_WIDTH) // MLSTM_HEADS
MLSTM_QK_DIM = MLSTM_V_DIM // 2
CHUNK = 128
D_FF = 2816
FFN_RESIDUAL_SCALE = 0.5
EPS = 1e-6
NEG_INF = -1e30
IN_SIZES = (CONV_WIDTH, CONV_WIDTH, CONV_WIDTH,
            MLSTM_HEADS * MLSTM_QK_DIM, MLSTM_HEADS * MLSTM_QK_DIM,
            MLSTM_HEADS * MLSTM_V_DIM, MLSTM_HEADS * MLSTM_V_DIM,
            2 * MLSTM_HEADS, 2 * MLSTM_HEADS)
W_IN_COLS = sum(IN_SIZES)

kernel_name = "hybrid_conv_mlstm_macaron_sandwich_encoder"


def rmsnorm(x, g):
    x32 = x.astype(jnp.float32)
    y = x32 * lax.rsqrt(jnp.mean(x32 * x32, axis=-1, keepdims=True) + EPS)
    return (y * g.astype(jnp.float32)).astype(x.dtype)


def swiglu(x, w_in, w_out):
    gate, up = jnp.split(x @ w_in, 2, axis=-1)
    return (jax.nn.silu(gate) * up) @ w_out


def mlstm_chunkwise(q, k, v, li, lf):
    B, H, S, DK = q.shape
    DV = v.shape[-1]
    NC = S // CHUNK
    q = q.reshape(B, H, NC, CHUNK, DK)
    k = k.reshape(B, H, NC, CHUNK, DK)
    v = v.reshape(B, H, NC, CHUNK, DV)
    li = li.reshape(B, H, NC, CHUNK)
    lf = lf.reshape(B, H, NC, CHUNK)
    b = jnp.cumsum(lf, axis=-1)
    g = b[..., -1]
    causal = jnp.tril(jnp.ones((CHUNK, CHUNK), dtype=bool))
    D = jnp.where(causal, b[..., :, None] - b[..., None, :] + li[..., None, :], NEG_INF)
    m_intra = jnp.max(D, axis=-1)
    w = g[..., None] - b + li
    m_chunk = jnp.max(w, axis=-1)
    e = jnp.exp(w - m_chunk[..., None])
    C_chunk = jnp.einsum('bhcl,bhclk,bhclv->bhckv', e, k, v)
    n_chunk = jnp.einsum('bhcl,bhclk->bhck', e, k)

    def step(carry, inp):
        C, n, m = carry
        g_c, Cc, nc, mc = inp
        m_new = jnp.maximum(g_c + m, mc)
        a = jnp.exp(g_c + m - m_new)
        s = jnp.exp(mc - m_new)
        C_new = a[..., None, None] * C + s[..., None, None] * Cc
        n_new = a[..., None] * n + s[..., None] * nc
        return (C_new, n_new, m_new), (C, n, m)

    init = (jnp.zeros((B, H, DK, DV), jnp.float32),
            jnp.zeros((B, H, DK), jnp.float32),
            jnp.full((B, H), NEG_INF, jnp.float32))
    xs = (jnp.moveaxis(g, 2, 0), jnp.moveaxis(C_chunk, 2, 0),
          jnp.moveaxis(n_chunk, 2, 0), jnp.moveaxis(m_chunk, 2, 0))
    _, (C_prev, n_prev, m_prev) = lax.scan(step, init, xs)
    C_prev = jnp.moveaxis(C_prev, 0, 2)
    n_prev = jnp.moveaxis(n_prev, 0, 2)
    m_prev = jnp.moveaxis(m_prev, 0, 2)

    m_inter = b + m_prev[..., None]
    m_t = jnp.maximum(m_inter, m_intra)
    P = jnp.exp(D - m_t[..., None]) * jnp.einsum('bhctk,bhcsk->bhcts', q, k)
    inter = jnp.exp(m_inter - m_t)
    numer = inter[..., None] * jnp.einsum('bhctk,bhckv->bhctv', q, C_prev) \
        + jnp.einsum('bhcts,bhcsv->bhctv', P, v)
    denom = inter * jnp.einsum('bhctk,bhck->bhct', q, n_prev) + jnp.sum(P, axis=-1)
    h = numer / jnp.maximum(jnp.abs(denom), jnp.exp(-m_t))[..., None]
    return h.reshape(B, H, S, DV)


def mixer(xn, w_in, conv_w, conv_b, gate_i_bias, gate_f_bias, head_gain, w_out):
    Bsz, S, _ = xn.shape
    H, DK, DV = MLSTM_HEADS, MLSTM_QK_DIM, MLSTM_V_DIM
    split_points = [int(p) for p in np.cumsum(IN_SIZES)[:-1]]
    bg, cg, hc, q, k, v, o, ig, fg = jnp.split(xn @ w_in, split_points, axis=-1)

    u = cg * hc
    u = lax.conv_general_dilated(u, conv_w[:, None, :].astype(u.dtype), window_strides=(1,),
                                 padding=[(1, 1)], dimension_numbers=('NWC', 'WIO', 'NWC'),
                                 feature_group_count=CONV_WIDTH)
    y_conv = bg * (u + conv_b.astype(u.dtype))

    def heads(t, d):
        return t.reshape(Bsz, S, H, d).transpose(0, 2, 1, 3).astype(jnp.float32)
    qh = heads(q, DK) * (DK ** -0.5)
    kh = heads(k, DK)
    vh = heads(v, DV)
    li = (ig.astype(jnp.float32) + gate_i_bias.astype(jnp.float32)).reshape(Bsz, S, 2, H).transpose(2, 0, 3, 1)
    lf = jax.nn.log_sigmoid(fg.astype(jnp.float32) + gate_f_bias.astype(jnp.float32)).reshape(Bsz, S, 2, H).transpose(2, 0, 3, 1)
    h_fwd = mlstm_chunkwise(qh, kh, vh, li[0], lf[0])
    flip = lambda t: jnp.flip(t, axis=2)
    h_bwd = flip(mlstm_chunkwise(flip(qh), flip(kh), flip(vh), flip(li[1]), flip(lf[1])))
    h = h_fwd + h_bwd
    h = h * lax.rsqrt(jnp.mean(h * h, axis=-1, keepdims=True) + EPS) \
        * head_gain.astype(jnp.float32).reshape(H, 1, DV)
    h = h.transpose(0, 2, 1, 3).reshape(Bsz, S, H * DV).astype(xn.dtype)
    y_mlstm = jax.nn.sigmoid(o) * h

    return jnp.concatenate([y_conv, y_mlstm], axis=-1) @ w_out


def setup_inputs(seed: int = 0) -> dict:
    key = jax.random.key(seed)
    ks = jax.random.split(key, 20)
    H = MLSTM_HEADS

    def nrm(k, shape, scale):
        return jax.random.normal(k, shape, jnp.float32) * scale

    def gain(k, n):
        return 1.0 + 0.05 * jax.random.normal(k, (DEPTH, n), jnp.float32)

    f_bias = jnp.tile(jnp.linspace(3.0, 6.0, H, dtype=jnp.float32), 2)[None, :] + nrm(ks[12], (DEPTH, 2 * H), 0.1)
    return {
        'x': jax.random.normal(ks[0], (BATCH, SEQ, D_MODEL), jnp.float32),
        'norm_ffn1_pre': gain(ks[1], D_MODEL),
        'norm_ffn1_post': gain(ks[2], D_MODEL),
        'w_ffn1_in': nrm(ks[3], (DEPTH, D_MODEL, 2 * D_FF), D_MODEL ** -0.5),
        'w_ffn1_out': nrm(ks[4], (DEPTH, D_FF, D_MODEL), D_FF ** -0.5),
        'norm_mix_pre': gain(ks[5], D_MODEL),
        'norm_mix_post': gain(ks[6], D_MODEL),
        'w_mix_in': nrm(ks[7], (DEPTH, D_MODEL, W_IN_COLS), D_MODEL ** -0.5),
        'conv_w': nrm(ks[8], (DEPTH, CONV_K, CONV_WIDTH), CONV_K ** -0.5),
        'conv_b': nrm(ks[9], (DEPTH, CONV_WIDTH), 0.02),
        'gate_i_bias': nrm(ks[10], (DEPTH, 2 * H), 0.1),
        'gate_f_bias': f_bias,
        'mlstm_norm': gain(ks[11], H * MLSTM_V_DIM),
        'w_mix_out': nrm(ks[13], (DEPTH, MIX_WIDTH, D_MODEL), MIX_WIDTH ** -0.5),
        'norm_ffn2_pre': gain(ks[14], D_MODEL),
        'norm_ffn2_post': gain(ks[15], D_MODEL),
        'w_ffn2_in': nrm(ks[16], (DEPTH, D_MODEL, 2 * D_FF), D_MODEL ** -0.5),
        'w_ffn2_out': nrm(ks[17], (DEPTH, D_FF, D_MODEL), D_FF ** -0.5),
    }


def reference(x, norm_ffn1_pre, norm_ffn1_post, w_ffn1_in, w_ffn1_out,
              norm_mix_pre, norm_mix_post, w_mix_in, conv_w, conv_b,
              gate_i_bias, gate_f_bias, mlstm_norm, w_mix_out,
              norm_ffn2_pre, norm_ffn2_post, w_ffn2_in, w_ffn2_out):
    for l in range(DEPTH):
        h = swiglu(rmsnorm(x, norm_ffn1_pre[l]), w_ffn1_in[l], w_ffn1_out[l])
        x = x + FFN_RESIDUAL_SCALE * rmsnorm(h, norm_ffn1_post[l])
        h = mixer(rmsnorm(x, norm_mix_pre[l]), w_mix_in[l], conv_w[l], conv_b[l],
                  gate_i_bias[l], gate_f_bias[l], mlstm_norm[l], w_mix_out[l])
        x = x + rmsnorm(h, norm_mix_post[l])
        h = swiglu(rmsnorm(x, norm_ffn2_pre[l]), w_ffn2_in[l], w_ffn2_out[l])
        x = x + FFN_RESIDUAL_SCALE * rmsnorm(h, norm_ffn2_post[l])
    return x
```

```cpp
#include <hip/hip_runtime.h>
#include <hip/hip_cooperative_groups.h>
#include <cstdio>
#include <cstdint>
namespace cg = cooperative_groups;
namespace pg8 {
#define PG8_LAS __attribute__((address_space(3)))
typedef unsigned short bf16_t;
typedef short bf16x8 __attribute__((ext_vector_type(8)));
typedef float f32x4 __attribute__((ext_vector_type(4)));
typedef unsigned u32x4 __attribute__((ext_vector_type(4)));
constexpr int BM = 256, BK = 64, HALF = 128, HTB = HALF * BK * 2  , STAGE_BYTES = 8 * HTB, NXCD = 8, WGM = 8;

__host__ __device__ __forceinline__ int lds_byte(int r, int c) { const int st = (r >> 4) * 2 + (c >> 5), rr = r & 15, cc = c & 31, ob = rr * 64 + cc * 2; return st * 1024 + (ob ^ (((ob >> 9) & 1) << 5)); }
__host__ __device__ __forceinline__ void stage_rc(int b, int& R, int& C) { const int st = b / 1024, sb = b % 1024, swz = sb ^ (((sb >> 9) & 1) << 5); R = (st >> 1) * 16 + swz / 64; C = (st & 1) * 32 + (swz % 64) / 2; }
__host__ __device__ __forceinline__ int perm32(int rho) { const int n = rho >> 4, i = rho & 15; return 8 * (i >> 2) + 4 * n + (i & 3); }

struct Unit { int pm, pn; };
struct Gemm { const bf16_t* A; const bf16_t* Bt; int M, N, K; };

struct StaticOrder {
    int nM, nN, nwg, G, c;
    __host__ __device__ void init(int M, int N, int G_, int c_) { nM = M / BM; nN = N / BM; nwg = nM * nN; G = G_; c = c_; }
    __host__ __device__ bool next(int i, Unit& u) const {
        const long L = (long)i * G + c; if (L >= nwg) return false;
        int wgid = (int)L; { const int q = nwg / NXCD, r = nwg % NXCD, xcd = wgid % NXCD, off = wgid / NXCD; wgid = (xcd < r ? xcd * (q + 1) : r * (q + 1) + (xcd - r) * q) + off; }
        const int nig = WGM * nN, gid = wgid / nig, fm = gid * WGM, gsz = (nM - fm) < WGM ? (nM - fm) : WGM;
        u.pm = fm + ((wgid % nig) % gsz); u.pn = (wgid % nig) / gsz; return true;
    }
    __device__ __forceinline__ void a_ready(const Unit&) const {}
    __device__ __forceinline__ void done(const Unit&) const {}
};

__device__ __forceinline__ unsigned cvt_pk_bf16(float lo, float hi) { unsigned r; asm volatile("v_cvt_pk_bf16_f32 %0, %1, %2" : "=v"(r) : "v"(lo), "v"(hi)); return r; }
typedef float f32x2 __attribute__((ext_vector_type(2)));
struct EpiBf16 {
    static constexpr bool PERM = true, AFTER_DRAIN = false;
    bf16_t* O; int ldc;
    __device__ __forceinline__ void operator()(const f32x4 (&acc)[2][2][4][2], const Unit& u, int wr, int wc, int fr, int fq) const {
        const int row0 = u.pm * BM + wr * 64 + fr; const int col0 = u.pn * BM + wc * 32 + 8 * fq;
#pragma unroll
        for (int ai = 0; ai < 2; ++ai)
#pragma unroll
            for (int m = 0; m < 4; ++m) { bf16_t* rowp = O + (size_t)(row0 + ai * HALF + m * 16) * ldc + col0;
#pragma unroll
                for (int bj = 0; bj < 2; ++bj) { const f32x4 v0 = acc[ai][bj][m][0], v1 = acc[ai][bj][m][1];
                    u32x4 w; w.x = cvt_pk_bf16(v0[0], v0[1]); w.y = cvt_pk_bf16(v0[2], v0[3]); w.z = cvt_pk_bf16(v1[0], v1[1]); w.w = cvt_pk_bf16(v1[2], v1[3]);
                    *(u32x4*)(rowp + bj * HALF) = w; } }
    }
};
__device__ __forceinline__ float silu_mul(float g, float u) { const float e = __expf(-g); return g * u * __builtin_amdgcn_rcpf(1.0f + e); }
struct EpiSwiglu {
    static constexpr bool PERM = true, AFTER_DRAIN = false;
    bf16_t* O; int ldc;
    __device__ __forceinline__ void operator()(const f32x4 (&acc)[2][2][4][2], const Unit& u, int wr, int wc, int fr, int fq) const {
        const int row0 = u.pm * BM + wr * 64 + fr; const int col0 = u.pn * HALF + wc * 32 + 8 * fq;
#pragma unroll
        for (int ai = 0; ai < 2; ++ai)
#pragma unroll
            for (int m = 0; m < 4; ++m) { bf16_t* rowp = O + (size_t)(row0 + ai * HALF + m * 16) * ldc + col0;
                const f32x4 g0 = acc[ai][0][m][0], g1 = acc[ai][0][m][1], u0 = acc[ai][1][m][0], u1 = acc[ai][1][m][1];
                u32x4 w;
                w.x = cvt_pk_bf16(silu_mul(g0[0], u0[0]), silu_mul(g0[1], u0[1])); w.y = cvt_pk_bf16(silu_mul(g0[2], u0[2]), silu_mul(g0[3], u0[3]));
                w.z = cvt_pk_bf16(silu_mul(g1[0], u1[0]), silu_mul(g1[1], u1[1])); w.w = cvt_pk_bf16(silu_mul(g1[2], u1[2]), silu_mul(g1[3], u1[3]));
                *(u32x4*)rowp = w; }
    }
};
template <class Epi, class Sched, bool ALIGN_EPI = false, bool SP2 = false>
__device__ __forceinline__ void gemm_phase(PG8_LAS unsigned char* lds, const Gemm g, const Sched& S, const Epi& E) {
    const int tid = threadIdx.x, wid = __builtin_amdgcn_readfirstlane(tid >> 6), lane = tid & 63, wr = wid >> 2, wc = wid & 3, fr = lane & 15, fq = lane >> 4;
    const int K = g.K, nt = K / BK;
    unsigned voffA[2], voffB[2];
#pragma unroll
    for (int i = 0; i < 2; ++i) { int R, C; stage_rc(tid * 16 + i * 8192, R, C); const int Rb = Epi::PERM ? ((R & ~31) + perm32(R & 31)) : R;
        voffA[i] = (unsigned)(R * K + C) * 2u; voffB[i] = (unsigned)(Rb * K + C) * 2u; }
    const size_t kstep = (size_t)(BK * 2);
    const size_t hstep = (size_t)HALF * K * 2;
    const size_t tstep = 2 * hstep;
    const unsigned ldsw = (unsigned)wid * 1024u;
    const int aoff = lds_byte(wr * 64 + fr, fq * 8), boff = lds_byte(wc * 32 + fr, fq * 8);
#define PG8_SA(b, h) (((b) * 2 + (h)) * HTB)
#define PG8_SB(b, h) ((4 + (b) * 2 + (h)) * HTB)
#define PG8_STAGE(bufoff, gbase, voff) do { _Pragma("unroll") for (int _i = 0; _i < 2; ++_i) \
        __builtin_amdgcn_global_load_lds((const unsigned*)((const char*)(gbase) + (voff)[_i]), (PG8_LAS unsigned*)(lds + (bufoff) + ldsw + _i * 8192), 16, 0, 0); } while (0)
#define PG8_LDA(dst, b, h) do { _Pragma("unroll") for (int m = 0; m < 4; ++m) _Pragma("unroll") for (int k = 0; k < 2; ++k) dst[m][k] = *(const PG8_LAS bf16x8*)(lds + PG8_SA(b, h) + aoff + m * 2048 + k * 1024); } while (0)
#define PG8_LDB(dst, b, h) do { _Pragma("unroll") for (int n = 0; n < 2; ++n) _Pragma("unroll") for (int k = 0; k < 2; ++k) dst[n][k] = *(const PG8_LAS bf16x8*)(lds + PG8_SB(b, h) + boff + n * 2048 + k * 1024); } while (0)
#define PG8_MMA(ai, bj, At, Bt) do { __builtin_amdgcn_s_setprio(1); _Pragma("unroll") for (int m = 0; m < 4; ++m) _Pragma("unroll") for (int n = 0; n < 2; ++n) _Pragma("unroll") for (int k = 0; k < 2; ++k) \
        acc[ai][bj][m][n] = __builtin_amdgcn_mfma_f32_16x16x32_bf16(Bt[n][k], At[m][k], acc[ai][bj][m][n], 0, 0, 0); __builtin_amdgcn_s_setprio(0); } while (0)
#define PG8_WAIT_V(n) asm volatile("s_waitcnt vmcnt(" #n ")" ::: "memory")
#define PG8_WAIT_L(n) asm volatile("s_waitcnt lgkmcnt(" #n ")" ::: "memory")
#define PG8_BAR __builtin_amdgcn_s_barrier()
#define PG8_SCHED __builtin_amdgcn_sched_barrier(0)
    Unit cur, nxt; int ui = 0;
    if (!S.next(0, cur)) return;
    f32x4 acc[2][2][4][2];
#pragma unroll
    for (int a = 0; a < 2; ++a)
#pragma unroll
        for (int b = 0; b < 2; ++b)
#pragma unroll
            for (int m = 0; m < 4; ++m)
#pragma unroll
                for (int n = 0; n < 2; ++n) acc[a][b][m][n] = (f32x4){0.f, 0.f, 0.f, 0.f};
    bf16x8 At[4][2], B0[2][2], B1[2][2];
    const char* cA = (const char*)g.A + (size_t)cur.pm * tstep; const char* cB = (const char*)g.Bt + (size_t)cur.pn * tstep;
    S.a_ready(cur);
    if constexpr (SP2) {
        PG8_STAGE(PG8_SB(0, 0), cB, voffB); PG8_STAGE(PG8_SB(0, 1), cB + hstep, voffB); PG8_STAGE(PG8_SA(0, 0), cA, voffA); PG8_STAGE(PG8_SA(0, 1), cA + hstep, voffA);
        if (wr == 1) PG8_BAR;
        PG8_WAIT_V(2); PG8_BAR;
        PG8_STAGE(PG8_SB(1, 0), cB + kstep, voffB); PG8_STAGE(PG8_SA(1, 0), cA + kstep, voffA); PG8_STAGE(PG8_SB(1, 1), cB + hstep + kstep, voffB);
        PG8_WAIT_V(6); PG8_BAR;
    } else {
        PG8_STAGE(PG8_SB(0, 0), cB, voffB); PG8_STAGE(PG8_SA(0, 0), cA, voffA); PG8_STAGE(PG8_SB(0, 1), cB + hstep, voffB); PG8_STAGE(PG8_SA(0, 1), cA + hstep, voffA);
        if (wr == 1) PG8_BAR;
        PG8_WAIT_V(4); PG8_BAR;
        PG8_STAGE(PG8_SB(1, 0), cB + kstep, voffB); PG8_STAGE(PG8_SA(1, 0), cA + kstep, voffA); PG8_STAGE(PG8_SB(1, 1), cB + hstep + kstep, voffB);
        PG8_WAIT_V(6); PG8_BAR;
    }
    for (;;) {
        const bool has_next = S.next(ui + 1, nxt);
        const char* nA = has_next ? (const char*)g.A + (size_t)nxt.pm * tstep : cA; const char* nB = has_next ? (const char*)g.Bt + (size_t)nxt.pn * tstep : cB;
        for (int t = 0; t < nt; t += 2) {
            const bool last = (t == nt - 2);
            const char* a1 = cA + (size_t)(t + 1) * kstep;
            const char* a2 = last ? nA : cA + (size_t)(t + 2) * kstep; const char* b2 = last ? nB : cB + (size_t)(t + 2) * kstep;
            const char* a3 = a2 + kstep; const char* b3 = b2 + kstep;
            if (last && has_next) S.a_ready(nxt);
            if constexpr (SP2) {
            PG8_LDB(B0, 0, 0); PG8_LDB(B1, 0, 1); PG8_SCHED; PG8_LDA(At, 0, 0); PG8_STAGE(PG8_SA(1, 1), a1 + hstep, voffA);
            PG8_WAIT_V(8); PG8_WAIT_L(0); PG8_BAR; PG8_MMA(0, 0, At, B0); PG8_MMA(0, 1, At, B1); PG8_BAR; PG8_SCHED;
            PG8_LDA(At, 0, 1); PG8_STAGE(PG8_SB(0, 0), b2, voffB); PG8_STAGE(PG8_SB(0, 1), b2 + hstep, voffB); PG8_STAGE(PG8_SA(0, 0), a2, voffA);
            PG8_WAIT_V(8); PG8_WAIT_L(0); PG8_BAR; PG8_MMA(1, 0, At, B0); PG8_MMA(1, 1, At, B1); PG8_BAR; PG8_SCHED;
            PG8_LDB(B0, 1, 0); PG8_LDB(B1, 1, 1); PG8_SCHED; PG8_LDA(At, 1, 0); PG8_STAGE(PG8_SA(0, 1), a2 + hstep, voffA);
            PG8_WAIT_V(8); PG8_WAIT_L(0); PG8_BAR; PG8_MMA(0, 0, At, B0); PG8_MMA(0, 1, At, B1); PG8_BAR; PG8_SCHED;
            PG8_LDA(At, 1, 1); PG8_STAGE(PG8_SB(1, 0), b3, voffB); PG8_STAGE(PG8_SB(1, 1), b3 + hstep, voffB); PG8_STAGE(PG8_SA(1, 0), a3, voffA);
            PG8_WAIT_V(8); PG8_WAIT_L(0); PG8_BAR; PG8_MMA(1, 0, At, B0); PG8_MMA(1, 1, At, B1); PG8_BAR; PG8_SCHED;
            } else {
            PG8_LDB(B0, 0, 0); PG8_SCHED; PG8_LDA(At, 0, 0); PG8_STAGE(PG8_SA(1, 1), a1 + hstep, voffA);
            PG8_WAIT_L(8); PG8_BAR; PG8_WAIT_L(0); PG8_MMA(0, 0, At, B0); PG8_BAR; PG8_SCHED;
            PG8_LDB(B1, 0, 1); PG8_STAGE(PG8_SB(0, 0), b2, voffB);
            PG8_BAR; PG8_WAIT_L(0); PG8_MMA(0, 1, At, B1); PG8_BAR;
            PG8_LDA(At, 0, 1); PG8_STAGE(PG8_SA(0, 0), a2, voffA);
            PG8_BAR; PG8_WAIT_L(0); PG8_MMA(1, 0, At, B0); PG8_BAR; PG8_SCHED;
            PG8_STAGE(PG8_SB(0, 1), b2 + hstep, voffB);
            PG8_WAIT_V(6); PG8_BAR; PG8_MMA(1, 1, At, B1); PG8_BAR;
            PG8_LDB(B0, 1, 0); PG8_SCHED; PG8_LDA(At, 1, 0); PG8_STAGE(PG8_SA(0, 1), a2 + hstep, voffA);
            PG8_WAIT_L(8); PG8_BAR; PG8_WAIT_L(0); PG8_MMA(0, 0, At, B0); PG8_BAR; PG8_SCHED;
            PG8_LDB(B1, 1, 1); PG8_STAGE(PG8_SB(1, 0), b3, voffB);
            PG8_BAR; PG8_WAIT_L(0); PG8_MMA(0, 1, At, B1); PG8_BAR;
            PG8_LDA(At, 1, 1); PG8_STAGE(PG8_SA(1, 0), a3, voffA);
            PG8_BAR; PG8_WAIT_L(0); PG8_MMA(1, 0, At, B0); PG8_BAR; PG8_SCHED;
            PG8_STAGE(PG8_SB(1, 1), b3 + hstep, voffB);
            PG8_WAIT_V(6); PG8_BAR; PG8_MMA(1, 1, At, B1); PG8_BAR;
            }
        }
        if constexpr (ALIGN_EPI) { if (wr == 0) PG8_BAR; }
        if constexpr (!Epi::AFTER_DRAIN) { E(acc, cur, wr, wc, fr, fq); S.done(cur); }
        if (!has_next) break;
#pragma unroll
        for (int a = 0; a < 2; ++a)
#pragma unroll
            for (int b = 0; b < 2; ++b)
#pragma unroll
                for (int m = 0; m < 4; ++m)
#pragma unroll
                    for (int n = 0; n < 2; ++n) acc[a][b][m][n] = (f32x4){0.f, 0.f, 0.f, 0.f};
        cur = nxt; cA = nA; cB = nB; ++ui;
        if constexpr (ALIGN_EPI) { if (wr == 1) PG8_BAR; }
    }
    PG8_WAIT_V(0);
    if constexpr (!ALIGN_EPI) { if (wr == 0) PG8_BAR; }
    PG8_BAR;
    if constexpr (Epi::AFTER_DRAIN) { E.fused(acc, cur, wr, wc, fr, fq, lds, wid, lane); S.done(cur); }
#undef PG8_SA
#undef PG8_SB
#undef PG8_STAGE
#undef PG8_LDA
#undef PG8_LDB
#undef PG8_MMA
#undef PG8_WAIT_V
#undef PG8_WAIT_L
#undef PG8_BAR
#undef PG8_SCHED
}
}

constexpr int NWAVES = 8, NTHR = NWAVES * 64;
constexpr int BATCH = 4, SEQ = 4096, D = 1024, FF = 2816, M = BATCH * SEQ;
constexpr int NZ = 3072, WINC = 3088;
constexpr int NH = 4, DK = 64, DV = 128, CH = 128, NC = SEQ / CH;
constexpr int Z_BG = 0, Z_CG = 512, Z_HC = 1024, Z_Q = 1536, Z_K = 1792, Z_V = 2048, Z_O = 2560;
constexpr float EPS = 1e-6f, NEG_INF = -1e30f;
constexpr int N_PHASES = 13;
#ifndef MK_CUTS
#define MK_CUTS {0, N_PHASES}
#endif

constexpr size_t MiB = 1u << 20;
constexpr size_t WS_W1I = 1 * MiB, WS_W1O = 12 * MiB, WS_WMI = 35 * MiB / 2, WS_WMO = 47 * MiB / 2, WS_W2I = 51 * MiB / 2, WS_W2O = 73 * MiB / 2, WS_WG = 42 * MiB;
constexpr size_t WS_XN = 44 * MiB;
constexpr size_t WS_ACT = 76 * MiB;
constexpr size_t WS_H = 172 * MiB;
constexpr size_t WS_G = 204 * MiB;
constexpr size_t WS_CC = 205 * MiB;
constexpr size_t WS_CP = 237 * MiB;
constexpr size_t WS_SM = 253 * MiB;
constexpr size_t WS_END = 254 * MiB;
constexpr int LDS_BYTES = 147456;

#define GAS __attribute__((address_space(1)))
#define LAS __attribute__((address_space(3)))
typedef unsigned short bf16;
typedef unsigned v4u __attribute__((ext_vector_type(4)));
typedef unsigned v2u __attribute__((ext_vector_type(2)));
typedef float f32x4 __attribute__((ext_vector_type(4)));
typedef short bf16x8 __attribute__((ext_vector_type(8)));
#define LDS_WAIT() asm volatile("s_waitcnt lgkmcnt(0)" ::: "memory")
__device__ __forceinline__ unsigned f2bf(float f) { unsigned u = __builtin_bit_cast(unsigned, f); return (u + 0x7fffu + ((u >> 16) & 1u)) >> 16; }
__device__ __forceinline__ unsigned pk2(float lo, float hi) { return f2bf(lo) | (f2bf(hi) << 16); }
__device__ __forceinline__ float bflo(unsigned w) { return __uint_as_float(w << 16); }
__device__ __forceinline__ float bfhi(unsigned w) { return __uint_as_float(w & 0xffff0000u); }
__device__ __forceinline__ float bf2f(bf16 h) { return __uint_as_float((unsigned)h << 16); }
typedef float f32x16 __attribute__((ext_vector_type(16)));
typedef float f32x2_t __attribute__((ext_vector_type(2))); typedef __bf16 bf16x2_t __attribute__((ext_vector_type(2)));
__device__ __forceinline__ unsigned cvtpk(float lo, float hi) { f32x2_t v = {lo, hi}; bf16x2_t b = __builtin_convertvector(v, bf16x2_t); return __builtin_bit_cast(unsigned, b); }
#define MFMA32(a, b, c) __builtin_amdgcn_mfma_f32_32x32x16_bf16((a), (b), (c), 0, 0, 0)
__device__ __forceinline__ float wave_sum(float v) {
#pragma unroll
    for (int o = 1; o < 64; o <<= 1) v += __shfl_xor(v, o);
    return v;
}

__device__ __forceinline__ void transpose_item(const float* __restrict__ W, int ldw, int k0, int c0, bf16* __restrict__ WT, int K, int r0, LAS float* scr, int lane) {
#pragma unroll 8
    for (int i = 0; i < 32; ++i) { const int kk = 2 * i + (lane >> 5); scr[kk * 33 + (lane & 31)] = W[(size_t)(k0 + kk) * ldw + c0 + (lane & 31)]; }
    LDS_WAIT(); asm volatile("" ::: "memory");
    const int c = lane & 7;
#pragma unroll
    for (int j = 0; j < 4; ++j) { const int n = (lane >> 3) + 8 * j; const LAS float* s = scr + (8 * c) * 33 + n;
        v4u o; o.x = pk2(s[0 * 33], s[1 * 33]); o.y = pk2(s[2 * 33], s[3 * 33]); o.z = pk2(s[4 * 33], s[5 * 33]); o.w = pk2(s[6 * 33], s[7 * 33]);
        *(v4u*)(WT + (size_t)(r0 + n) * K + k0 + 8 * c) = o; }
    LDS_WAIT(); asm volatile("" ::: "memory");
}
__device__ __forceinline__ int swiglu_row(int c0) { const int s = c0 / FF, j = c0 % FF; return 256 * (j / 128) + 128 * s + (j % 128); }

template <bool HAS_H, bool HAS_NEXT>
__device__ __forceinline__ void norm_rows(const float* xin, const bf16* H, const float* gpost, float scale, float* xout, const float* gpre, bf16* XN, int gw, int NGW, int lane) {
    f32x4 gp[4], gn[4];
#pragma unroll
    for (int j = 0; j < 4; ++j) { if (HAS_H) gp[j] = ((const f32x4*)gpost)[lane + 64 * j]; if (HAS_NEXT) gn[j] = ((const f32x4*)gpre)[lane + 64 * j]; }
    for (int m = gw; m < M; m += NGW) {
        f32x4 v[4];
#pragma unroll
        for (int j = 0; j < 4; ++j) v[j] = ((const f32x4*)(xin + (size_t)m * D))[lane + 64 * j];
        if (HAS_H) {
            f32x4 hv[4]; float s = 0.f;
#pragma unroll
            for (int j = 0; j < 4; ++j) { const v2u w = ((const v2u*)(H + (size_t)m * D))[lane + 64 * j]; hv[j] = (f32x4){bflo(w.x), bfhi(w.x), bflo(w.y), bfhi(w.y)};
                s += (hv[j].x * hv[j].x + hv[j].y * hv[j].y) + (hv[j].z * hv[j].z + hv[j].w * hv[j].w); }
            const float rh = scale / sqrtf(wave_sum(s) * (1.f / D) + EPS);
#pragma unroll
            for (int j = 0; j < 4; ++j) { v[j] = v[j] + hv[j] * gp[j] * rh; ((f32x4*)(xout + (size_t)m * D))[lane + 64 * j] = v[j]; }
        }
        if (HAS_NEXT) {
            float s = 0.f;
#pragma unroll
            for (int j = 0; j < 4; ++j) s += (v[j].x * v[j].x + v[j].y * v[j].y) + (v[j].z * v[j].z + v[j].w * v[j].w);
            const float r = 1.0f / sqrtf(wave_sum(s) * (1.f / D) + EPS);
#pragma unroll
            for (int j = 0; j < 4; ++j) { const f32x4 o = v[j] * gn[j] * r; v2u w; w.x = pk2(o.x, o.y); w.y = pk2(o.z, o.w); ((v2u*)(XN + (size_t)m * D))[lane + 64 * j] = w; }
        }
    }
}

__device__ __forceinline__ void ld8(const bf16* p, float (&o)[8]) { const v4u w = *(const v4u*)p; o[0] = bflo(w.x); o[1] = bfhi(w.x); o[2] = bflo(w.y); o[3] = bfhi(w.y); o[4] = bflo(w.z); o[5] = bfhi(w.z); o[6] = bflo(w.w); o[7] = bfhi(w.w); }

struct Args { const float* in[18]; float* out; unsigned char* ws; int ph_lo, ph_hi; };
__global__ void __launch_bounds__(NTHR, 2) fwd(Args args) {
    extern __shared__ __attribute__((aligned(16))) unsigned char lds_raw[];
    LAS unsigned char* lds = (LAS unsigned char*)lds_raw;
    cg::grid_group grid = cg::this_grid();
    const int tid = threadIdx.x, lane = tid & 63, wave = __builtin_amdgcn_readfirstlane(tid >> 6);
    const int G = gridDim.x, gw = blockIdx.x * NWAVES + wave, NGW = G * NWAVES;
    unsigned char* ws = args.ws;
    const float* x = args.in[0]; float* out = args.out;
    bf16* W1I = (bf16*)(ws + WS_W1I); bf16* W1O = (bf16*)(ws + WS_W1O); bf16* WMI = (bf16*)(ws + WS_WMI); bf16* WMO = (bf16*)(ws + WS_WMO);
    bf16* W2I = (bf16*)(ws + WS_W2I); bf16* W2O = (bf16*)(ws + WS_W2O); bf16* WGT = (bf16*)(ws + WS_WG);
    bf16* XN = (bf16*)(ws + WS_XN); bf16* Y = XN; bf16* ACT = (bf16*)(ws + WS_ACT); bf16* Z = ACT; bf16* H = (bf16*)(ws + WS_H);
    float* Gt = (float*)(ws + WS_G); float* CC = (float*)(ws + WS_CC); bf16* CP = (bf16*)(ws + WS_CP);
    float* NCc = (float*)(ws + WS_SM); float* NPp = NCc + 1024 * 64; float* GC = NPp + 1024 * 64; float* MC = GC + 1024; float* MP = MC + 1024;
    const int lo = args.ph_lo, hi = args.ph_hi;
#define IN(k) (lo <= (k) && (k) < hi)
#define SEAM(k) do { if (IN(k) && IN((k) + 1)) grid.sync(); } while (0)

    if (IN(0)) {
        LAS float* scr = (LAS float*)(lds + wave * 16384);
        constexpr int I_FI = 16 * 176, I_FO = 44 * 32, I_MI = 16 * 96, I_MO = 16 * 32, NITEMS = 2 * (I_FI + I_FO) + I_MI + I_MO;
        for (int it = gw; it < NITEMS; it += NGW) {
            int r = it;
            if (r < I_FI) { const int kb = r / 176, nb = r % 176; transpose_item(args.in[3], 2 * FF, 64 * kb, 32 * nb, W1I, D, swiglu_row(32 * nb), scr, lane); continue; } r -= I_FI;
            if (r < I_FI) { const int kb = r / 176, nb = r % 176; transpose_item(args.in[16], 2 * FF, 64 * kb, 32 * nb, W2I, D, swiglu_row(32 * nb), scr, lane); continue; } r -= I_FI;
            if (r < I_FO) { const int kb = r / 32, nb = r % 32; transpose_item(args.in[4], D, 64 * kb, 32 * nb, W1O, FF, 32 * nb, scr, lane); continue; } r -= I_FO;
            if (r < I_FO) { const int kb = r / 32, nb = r % 32; transpose_item(args.in[17], D, 64 * kb, 32 * nb, W2O, FF, 32 * nb, scr, lane); continue; } r -= I_FO;
            if (r < I_MI) { const int kb = r / 96, nb = r % 96; transpose_item(args.in[7], WINC, 64 * kb, 32 * nb, WMI, D, 32 * nb, scr, lane); continue; } r -= I_MI;
            { const int kb = r / 32, nb = r % 32; transpose_item(args.in[13], D, 64 * kb, 32 * nb, WMO, D, 32 * nb, scr, lane); }
        }
        for (int e = blockIdx.x * NTHR + tid; e < 16 * D; e += G * NTHR) { const int g = e / D, k = e % D; WGT[e] = (bf16)f2bf(args.in[7][(size_t)k * WINC + NZ + g]); }
        norm_rows<false, true>(x, nullptr, nullptr, 0.f, nullptr, args.in[1], XN, gw, NGW, lane);
    }
    SEAM(0);
    if (IN(1)) {
        pg8::Gemm g{XN, W1I, M, 2 * FF, D}; pg8::StaticOrder S; S.init(M, 2 * FF, G, (int)blockIdx.x);
        pg8::EpiSwiglu E{ACT, FF};
        pg8::gemm_phase<pg8::EpiSwiglu, pg8::StaticOrder, true, true>(lds, g, S, E);
    }
    SEAM(1);
    if (IN(2)) {
        pg8::Gemm g{ACT, W1O, M, D, FF}; pg8::StaticOrder S; S.init(M, D, G, (int)blockIdx.x);
        pg8::EpiBf16 E{H, D};
        pg8::gemm_phase<pg8::EpiBf16, pg8::StaticOrder, true, true>(lds, g, S, E);
    }
    SEAM(2);
    if (IN(3)) norm_rows<true, true>(x, H, args.in[2], 0.5f, out, args.in[5], XN, gw, NGW, lane);
    SEAM(3);
    if (IN(4)) {
        const int fr = lane & 15, fq = lane >> 4;
        for (int rb = gw; rb < M / 16; rb += NGW) {
            f32x4 acc = {0.f, 0.f, 0.f, 0.f};
            const bf16* arow = XN + (size_t)(rb * 16 + fr) * D + fq * 8; const bf16* brow = WGT + (size_t)fr * D + fq * 8;
#pragma unroll 8
            for (int kk = 0; kk < D / 32; ++kk) { const bf16x8 a = *(const bf16x8*)(arow + kk * 32); const bf16x8 b = *(const bf16x8*)(brow + kk * 32);
                acc = __builtin_amdgcn_mfma_f32_16x16x32_bf16(b, a, acc, 0, 0, 0); }
            f32x4 o;
#pragma unroll
            for (int i = 0; i < 4; ++i) { const int gcol = 4 * fq + i;
                if (gcol < 8) o[i] = acc[i] + args.in[10][gcol];
                else { const float v = acc[i] + args.in[11][gcol - 8]; o[i] = fminf(v, 0.f) - log1pf(__expf(-fabsf(v))); } }
            *(f32x4*)(Gt + (size_t)(rb * 16 + fr) * 16 + 4 * fq) = o;
        }
        pg8::Gemm g{XN, WMI, M, NZ, D}; pg8::StaticOrder S; S.init(M, NZ, G, (int)blockIdx.x);
        pg8::EpiBf16 E{Z, NZ};
        pg8::gemm_phase<pg8::EpiBf16, pg8::StaticOrder, true, true>(lds, g, S, E);
    }
    SEAM(4);
    if (IN(5)) {
        LAS float* Ks = (LAS float*)lds; LAS float* Vs = Ks + CH * DK; LAS float* lfv = Vs + CH * DV; LAS float* liv = lfv + CH; LAS float* wv = liv + CH; LAS float* ev = wv + CH;
        for (int it = blockIdx.x; it < 2 * BATCH * NH * NC; it += G) {
            const int dir = it >> 9, b = (it >> 7) & 3, h = (it >> 5) & 3, c = it & 31, r0 = b * SEQ + c * CH;
            __syncthreads();
#pragma unroll
            for (int j = 0; j < 2; ++j) { const int e = tid + NTHR * j, row = e >> 3, c8 = e & 7; float f[8]; ld8(Z + (size_t)(r0 + row) * NZ + Z_K + h * DK + c8 * 8, f);
#pragma unroll
                for (int i = 0; i < 8; ++i) Ks[row * DK + c8 * 8 + i] = f[i]; }
#pragma unroll
            for (int j = 0; j < 4; ++j) { const int e = tid + NTHR * j, row = e >> 4, c8 = e & 15; float f[8]; ld8(Z + (size_t)(r0 + row) * NZ + Z_V + h * DV + c8 * 8, f);
#pragma unroll
                for (int i = 0; i < 8; ++i) Vs[row * DV + c8 * 8 + i] = f[i]; }
            if (tid < CH) { liv[tid] = Gt[(size_t)(r0 + tid) * 16 + dir * 4 + h]; lfv[tid] = Gt[(size_t)(r0 + tid) * 16 + 8 + dir * 4 + h]; }
            __syncthreads();
            float gsum = 0.f;
            if (tid < CH) { float bsum = 0.f;
                for (int s = 0; s < CH; ++s) { const float lf = lfv[s]; gsum += lf; if (dir ? (s >= tid) : (s <= tid)) bsum += lf; }
                wv[tid] = gsum - bsum + liv[tid]; }
            __syncthreads();
            if (tid < CH) { float mx = -3.0e38f;
                for (int s = 0; s < CH; ++s) mx = fmaxf(mx, wv[s]);
                ev[tid] = __expf(wv[tid] - mx);
                if (tid == 0) { GC[it] = gsum; MC[it] = mx; } }
            __syncthreads();
            const int dk = tid & 63, dv0 = tid >> 6;
            float acc[16]; float nacc = 0.f;
#pragma unroll
            for (int j = 0; j < 16; ++j) acc[j] = 0.f;
            for (int t = 0; t < CH; ++t) { const float kv = ev[t] * Ks[t * DK + dk]; nacc += kv;
#pragma unroll
                for (int j = 0; j < 16; ++j) acc[j] += kv * Vs[t * DV + dv0 + 8 * j]; }
#pragma unroll
            for (int j = 0; j < 16; ++j) CC[(size_t)it * (DV * DK) + (dv0 + 8 * j) * DK + dk] = acc[j];
            if (tid < DK) NCc[it * DK + tid] = nacc;
        }
        const float* cw = args.in[8]; const float* cb = args.in[9];
        for (int rb = blockIdx.x; rb < M / 64; rb += G) {
            const int c0 = (tid & 63) * 8, rsub = tid >> 6;
            float w0[8], w1[8], w2[8], bb[8];
#pragma unroll
            for (int i = 0; i < 8; ++i) { w0[i] = cw[c0 + i]; w1[i] = cw[512 + c0 + i]; w2[i] = cw[1024 + c0 + i]; bb[i] = cb[c0 + i]; }
            for (int p = 0; p < 8; ++p) {
                const int row = rb * 64 + p * 8 + rsub, t = row & (SEQ - 1);
                float a[8], bq[8], um[8], u0[8], up[8], bg[8];
                ld8(Z + (size_t)row * NZ + Z_CG + c0, a); ld8(Z + (size_t)row * NZ + Z_HC + c0, bq);
#pragma unroll
                for (int i = 0; i < 8; ++i) u0[i] = a[i] * bq[i];
                if (t > 0) { ld8(Z + (size_t)(row - 1) * NZ + Z_CG + c0, a); ld8(Z + (size_t)(row - 1) * NZ + Z_HC + c0, bq);
#pragma unroll
                    for (int i = 0; i < 8; ++i) um[i] = a[i] * bq[i]; }
                else {
#pragma unroll
                    for (int i = 0; i < 8; ++i) um[i] = 0.f; }
                if (t < SEQ - 1) { ld8(Z + (size_t)(row + 1) * NZ + Z_CG + c0, a); ld8(Z + (size_t)(row + 1) * NZ + Z_HC + c0, bq);
#pragma unroll
                    for (int i = 0; i < 8; ++i) up[i] = a[i] * bq[i]; }
                else {
#pragma unroll
                    for (int i = 0; i < 8; ++i) up[i] = 0.f; }
                ld8(Z + (size_t)row * NZ + Z_BG + c0, bg);
                float y[8];
#pragma unroll
                for (int i = 0; i < 8; ++i) y[i] = bg[i] * (w0[i] * um[i] + w1[i] * u0[i] + w2[i] * up[i] + bb[i]);
                v4u o; o.x = pk2(y[0], y[1]); o.y = pk2(y[2], y[3]); o.z = pk2(y[4], y[5]); o.w = pk2(y[6], y[7]);
                *(v4u*)(Y + (size_t)row * D + c0) = o;
            }
        }
    }
    SEAM(5);
    if (IN(6)) {
        LAS float* sa = (LAS float*)lds; LAS float* ss = sa + 128;
        for (int unit = blockIdx.x; unit < 256; unit += G) {
            const int seq = unit >> 3, part = unit & 7, dir = seq >> 4;
            __syncthreads();
            if (tid < NC) { const int it = seq * NC + (dir ? NC - 1 - tid : tid); sa[64 + tid] = GC[it]; ss[64 + tid] = MC[it]; }
            __syncthreads();
            if (tid == 0) { float m = NEG_INF;
                for (int ci = 0; ci < NC; ++ci) { const int it = seq * NC + (dir ? NC - 1 - ci : ci);
                    if (part == 0) MP[it] = m;
                    const float gcv = sa[64 + ci], mcv = ss[64 + ci], mn = fmaxf(gcv + m, mcv);
                    sa[ci] = __expf(gcv + m - mn); ss[ci] = __expf(mcv - mn); m = mn; } }
            __syncthreads();
            const int e0 = part * 1024 + 2 * tid;
            float c0 = 0.f, c1 = 0.f, n = 0.f;
#pragma unroll 4
            for (int ci = 0; ci < NC; ++ci) { const int it = seq * NC + (dir ? NC - 1 - ci : ci);
                *(unsigned*)(CP + (size_t)it * (DV * DK) + e0) = pk2(c0, c1);
                const float2 cc = *(const float2*)(CC + (size_t)it * (DV * DK) + e0);
                const float a = sa[ci], s = ss[ci];
                c0 = a * c0 + s * cc.x; c1 = a * c1 + s * cc.y;
                if (part == 0 && tid < DK) { NPp[it * DK + tid] = n; n = a * n + s * NCc[it * DK + tid]; } }
        }
    }
    SEAM(6);
    if (IN(7)) {
        constexpr int QP = 72, VP = 132, HP = 132;
        LAS bf16* Qs = (LAS bf16*)lds; LAS bf16* Ks = Qs + CH * QP; LAS bf16* VTs = Ks + CH * QP;
        LAS float* gv = (LAS float*)(VTs + DV * VP);
        LAS float* HB = gv + 2 * 6 * CH;
        const float* hgain = args.in[12];
        const int l31 = lane & 31, hh = lane >> 5, d = wave >> 2, rb = wave & 3;
        for (int it2 = blockIdx.x; it2 < BATCH * NH * NC; it2 += G) {
            const int b = it2 >> 7, h = (it2 >> 5) & 3, c = it2 & 31, r0 = b * SEQ + c * CH;
            __syncthreads();
#pragma unroll
            for (int j = 0; j < 2; ++j) { const int e = tid + NTHR * j, row = e >> 3, c8 = e & 7;
                const v4u wq = *(const v4u*)(Z + (size_t)(r0 + row) * NZ + Z_Q + h * DK + c8 * 8); v4u o;
                o.x = pk2(bflo(wq.x) * 0.125f, bfhi(wq.x) * 0.125f); o.y = pk2(bflo(wq.y) * 0.125f, bfhi(wq.y) * 0.125f); o.z = pk2(bflo(wq.z) * 0.125f, bfhi(wq.z) * 0.125f); o.w = pk2(bflo(wq.w) * 0.125f, bfhi(wq.w) * 0.125f);
                *(LAS v4u*)(Qs + row * QP + c8 * 8) = o;
                *(LAS v4u*)(Ks + row * QP + c8 * 8) = *(const v4u*)(Z + (size_t)(r0 + row) * NZ + Z_K + h * DK + c8 * 8); }
#pragma unroll
            for (int j = 0; j < 4; ++j) { const int e = tid + NTHR * j, sr = e & 127, c16 = e >> 7;
                const v4u w = *(const v4u*)(Z + (size_t)(r0 + sr) * NZ + Z_V + h * DV + c16 * 8); LAS bf16* vp = VTs + (c16 * 8) * VP + sr;
                vp[0 * VP] = (bf16)(w.x & 0xffffu); vp[1 * VP] = (bf16)(w.x >> 16); vp[2 * VP] = (bf16)(w.y & 0xffffu); vp[3 * VP] = (bf16)(w.y >> 16);
                vp[4 * VP] = (bf16)(w.z & 0xffffu); vp[5 * VP] = (bf16)(w.z >> 16); vp[6 * VP] = (bf16)(w.w & 0xffffu); vp[7 * VP] = (bf16)(w.w >> 16); }
            const int gd = tid >> 7, gt = tid & 127;
            if (tid < 2 * CH) { HB[gd * CH + gt] = Gt[(size_t)(r0 + gt) * 16 + 8 + gd * 4 + h]; HB[2 * CH + gd * CH + gt] = Gt[(size_t)(r0 + gt) * 16 + gd * 4 + h]; }
            __syncthreads();
            if (tid < 2 * CH) { float bsum = 0.f;
                for (int s = 0; s < CH; ++s) { const float lf = HB[gd * CH + s]; if (gd ? (s >= gt) : (s <= gt)) bsum += lf; }
                gv[(gd * 6 + 0) * CH + gt] = bsum; gv[(gd * 6 + 1) * CH + gt] = HB[2 * CH + gd * CH + gt] - bsum; }
            __syncthreads();
            if (tid < 2 * CH) { float mi = -3.0e38f;
                for (int s = 0; s < CH; ++s) { if (gd ? (s >= gt) : (s <= gt)) mi = fmaxf(mi, gv[(gd * 6 + 1) * CH + s]); }
                const float bt = gv[(gd * 6 + 0) * CH + gt], mprev = MP[((gd * BATCH + b) * NH + h) * NC + c], minter = bt + mprev, mt = fmaxf(minter, bt + mi);
                gv[(gd * 6 + 2) * CH + gt] = bt - mt; gv[(gd * 6 + 3) * CH + gt] = __expf(minter - mt); gv[(gd * 6 + 4) * CH + gt] = __expf(-mt); }
            __syncthreads();
            const int it = ((d * BATCH + b) * NH + h) * NC + c;
            const LAS float* gvd = gv + d * 6 * CH;
            bf16x8 qf[4];
#pragma unroll
            for (int kk = 0; kk < 4; ++kk) qf[kk] = *(const LAS bf16x8*)(Qs + (32 * rb + l31) * QP + 16 * kk + 8 * hh);
            f32x16 acc[4];
#pragma unroll
            for (int nt = 0; nt < 4; ++nt) {
#pragma unroll
                for (int i = 0; i < 16; ++i) acc[nt][i] = 0.f;
#pragma unroll
                for (int kk = 0; kk < 4; ++kk) { const bf16x8 cb = *(const bf16x8*)(CP + (size_t)it * (DV * DK) + (32 * nt + l31) * DK + 16 * kk + 8 * hh); acc[nt] = MFMA32(qf[kk], cb, acc[nt]); } }
#pragma unroll
            for (int g = 0; g < 4; ++g) { const f32x4 iv = *(const LAS f32x4*)(gvd + 3 * CH + 32 * rb + 8 * g + 4 * hh);
#pragma unroll
                for (int nt = 0; nt < 4; ++nt)
#pragma unroll
                    for (int i = 0; i < 4; ++i) acc[nt][4 * g + i] *= iv[i]; }
            const float alpha_t = gvd[2 * CH + 32 * rb + l31]; float rowsum = 0.f;
#pragma unroll 1
            for (int sb = 0; sb < 4; ++sb) {
                if (d == 0 ? (sb > rb) : (sb < rb)) continue;
                f32x16 xx;
#pragma unroll
                for (int i = 0; i < 16; ++i) xx[i] = 0.f;
#pragma unroll
                for (int kk = 0; kk < 4; ++kk) { const bf16x8 kf = *(const LAS bf16x8*)(Ks + (32 * sb + l31) * QP + 16 * kk + 8 * hh); xx = MFMA32(kf, qf[kk], xx); }
                const int tl = 32 * rb + l31;
#pragma unroll
                for (int g = 0; g < 4; ++g) { const f32x4 bv = *(const LAS f32x4*)(gvd + 1 * CH + 32 * sb + 8 * g + 4 * hh);
#pragma unroll
                    for (int i = 0; i < 4; ++i) { const int sl = 32 * sb + 8 * g + 4 * hh + i; const bool valid = d == 0 ? (sl <= tl) : (sl >= tl);
                        const float p = valid ? __expf(alpha_t + bv[i]) * xx[4 * g + i] : 0.f; xx[4 * g + i] = p; rowsum += p; } }
#pragma unroll
                for (int ks = 0; ks < 2; ++ks) {
                    v4u pw; pw.x = cvtpk(xx[8 * ks + 0], xx[8 * ks + 1]); pw.y = cvtpk(xx[8 * ks + 2], xx[8 * ks + 3]); pw.z = cvtpk(xx[8 * ks + 4], xx[8 * ks + 5]); pw.w = cvtpk(xx[8 * ks + 6], xx[8 * ks + 7]);
                    const bf16x8 pa = __builtin_bit_cast(bf16x8, pw);
#pragma unroll
                    for (int nt = 0; nt < 4; ++nt) { const LAS bf16* vp = VTs + (32 * nt + l31) * VP + 32 * sb + 16 * ks + 4 * hh;
                        const v2u lo = *(const LAS v2u*)vp, hi2 = *(const LAS v2u*)(vp + 8); v4u vw; vw.x = lo.x; vw.y = lo.y; vw.z = hi2.x; vw.w = hi2.y;
                        acc[nt] = MFMA32(pa, __builtin_bit_cast(bf16x8, vw), acc[nt]); } }
            }
            rowsum += __shfl_xor(rowsum, 32);
            float qn = 0.f;
#pragma unroll
            for (int i = 0; i < 32; ++i) qn += bf2f(Qs[(32 * rb + l31) * QP + 32 * hh + i]) * NPp[it * DK + 32 * hh + i];
            qn += __shfl_xor(qn, 32);
            { const float denom = gvd[3 * CH + 32 * rb + l31] * qn + rowsum; gv[(d * 6 + 5) * CH + 32 * rb + l31] = 1.0f / fmaxf(fabsf(denom), gvd[4 * CH + 32 * rb + l31]); }
            LDS_WAIT();
#pragma unroll
            for (int g = 0; g < 4; ++g) { const f32x4 dv4 = *(const LAS f32x4*)(gvd + 5 * CH + 32 * rb + 8 * g + 4 * hh);
#pragma unroll
                for (int nt = 0; nt < 4; ++nt)
#pragma unroll
                    for (int i = 0; i < 4; ++i) acc[nt][4 * g + i] *= dv4[i]; }
            if (d == 1) {
#pragma unroll
                for (int nt = 0; nt < 4; ++nt)
#pragma unroll
                    for (int i = 0; i < 16; ++i) HB[(32 * rb + (i & 3) + 8 * (i >> 2) + 4 * hh) * HP + 32 * nt + l31] = acc[nt][i]; }
            __syncthreads();
            if (d == 0) {
#pragma unroll
                for (int nt = 0; nt < 4; ++nt)
#pragma unroll
                    for (int i = 0; i < 16; ++i) HB[(32 * rb + (i & 3) + 8 * (i >> 2) + 4 * hh) * HP + 32 * nt + l31] += acc[nt][i]; }
            __syncthreads();
            { const int t = tid >> 2, dvq = tid & 3; f32x4 hv[8]; float sq = 0.f;
#pragma unroll
                for (int j = 0; j < 8; ++j) { hv[j] = *(const LAS f32x4*)(HB + t * HP + dvq * 32 + 4 * j); sq += (hv[j].x * hv[j].x + hv[j].y * hv[j].y) + (hv[j].z * hv[j].z + hv[j].w * hv[j].w); }
                sq += __shfl_xor(sq, 1); sq += __shfl_xor(sq, 2);
                const float r = 1.0f / sqrtf(sq * (1.f / DV) + EPS);
#pragma unroll
                for (int j8 = 0; j8 < 4; ++j8) { float o[8]; ld8(Z + (size_t)(r0 + t) * NZ + Z_O + h * DV + dvq * 32 + j8 * 8, o);
                    const f32x4 g0 = *(const f32x4*)(hgain + h * DV + dvq * 32 + j8 * 8), g1 = *(const f32x4*)(hgain + h * DV + dvq * 32 + j8 * 8 + 4);
                    const f32x4 a0 = hv[2 * j8], a1 = hv[2 * j8 + 1]; float y[8];
#pragma unroll
                    for (int i = 0; i < 4; ++i) { y[i] = a0[i] * r * g0[i] / (1.0f + __expf(-o[i])); y[4 + i] = a1[i] * r * g1[i] / (1.0f + __expf(-o[4 + i])); }
                    v4u w; w.x = pk2(y[0], y[1]); w.y = pk2(y[2], y[3]); w.z = pk2(y[4], y[5]); w.w = pk2(y[6], y[7]);
                    *(v4u*)(Y + (size_t)(r0 + t) * D + 512 + h * DV + dvq * 32 + j8 * 8) = w; } }
        }
    }
    SEAM(7);
    if (IN(8)) {
        pg8::Gemm g{Y, WMO, M, D, D}; pg8::StaticOrder S; S.init(M, D, G, (int)blockIdx.x);
        pg8::EpiBf16 E{H, D};
        pg8::gemm_phase<pg8::EpiBf16, pg8::StaticOrder, true, true>(lds, g, S, E);
    }
    SEAM(8);
    if (IN(9)) norm_rows<true, true>(out, H, args.in[6], 1.0f, out, args.in[14], XN, gw, NGW, lane);
    SEAM(9);
    if (IN(10)) {
        pg8::Gemm g{XN, W2I, M, 2 * FF, D}; pg8::StaticOrder S; S.init(M, 2 * FF, G, (int)blockIdx.x);
        pg8::EpiSwiglu E{ACT, FF};
        pg8::gemm_phase<pg8::EpiSwiglu, pg8::StaticOrder, true, true>(lds, g, S, E);
    }
    SEAM(10);
    if (IN(11)) {
        pg8::Gemm g{ACT, W2O, M, D, FF}; pg8::StaticOrder S; S.init(M, D, G, (int)blockIdx.x);
        pg8::EpiBf16 E{H, D};
        pg8::gemm_phase<pg8::EpiBf16, pg8::StaticOrder, true, true>(lds, g, S, E);
    }
    SEAM(11);
    if (IN(12)) norm_rows<true, false>(out, H, args.in[15], 0.5f, out, nullptr, nullptr, gw, NGW, lane);
#undef IN
#undef SEAM
}

extern "C" void kernel_launch(void* const* d_in, const int* in_sizes, int n_in, void* d_out, int out_size, void* d_ws, size_t ws_size, hipStream_t stream) {
    static int grid = 0;
    if (grid == 0) {
        if (n_in != 18 || in_sizes[0] != M * D || out_size != M * D || ws_size < WS_END) { fprintf(stderr, "kernel_launch: unexpected shapes (n_in %d, in0 %d, out %d, ws %zu)\n", n_in, n_in > 0 ? in_sizes[0] : -1, out_size, ws_size); grid = -1; return; }
        int dev = 0, cus = 0, per_cu = 0;
        if (hipGetDevice(&dev) != hipSuccess || hipDeviceGetAttribute(&cus, hipDeviceAttributeMultiprocessorCount, dev) != hipSuccess) { grid = -1; return; }
        if (hipFuncSetAttribute((const void*)fwd, hipFuncAttributeMaxDynamicSharedMemorySize, LDS_BYTES) != hipSuccess) { fprintf(stderr, "kernel_launch: hipFuncSetAttribute failed\n"); grid = -1; return; }
        if (hipOccupancyMaxActiveBlocksPerMultiprocessor(&per_cu, (const void*)fwd, NTHR, LDS_BYTES) != hipSuccess || per_cu < 1) { fprintf(stderr, "kernel_launch: occupancy query says %d blocks per CU\n", per_cu); grid = -1; return; }
        grid = cus;
    }
    if (grid < 0) return;
    Args a{};
    for (int i = 0; i < 18; ++i) a.in[i] = (const float*)d_in[i];
    a.out = (float*)d_out; a.ws = (unsigned char*)d_ws;
    const int cuts[] = MK_CUTS;
    const int ncuts = (int)(sizeof(cuts) / sizeof(cuts[0]));
    for (int li = 0; li + 1 < ncuts; ++li) {
        a.ph_lo = cuts[li]; a.ph_hi = cuts[li + 1];
        void* kargs[] = {&a};
        const hipError_t le = hipLaunchCooperativeKernel((const void*)fwd, dim3(grid), dim3(NTHR), kargs, LDS_BYTES, stream);
        if (le != hipSuccess) { fprintf(stderr, "kernel_launch: cooperative launch %d failed: %s (grid %d)\n", li, hipGetErrorString(le), grid); break; }
    }
}
```

```cpp
#include <hip/hip_runtime.h>
#include <hip/hip_cooperative_groups.h>
#include <cstdio>
#include <cstdint>
namespace cg = cooperative_groups;
namespace pg8 {
#define PG8_LAS __attribute__((address_space(3)))
typedef unsigned short bf16_t;
typedef short bf16x8 __attribute__((ext_vector_type(8)));
typedef float f32x4 __attribute__((ext_vector_type(4)));
typedef unsigned u32x4 __attribute__((ext_vector_type(4)));
constexpr int BM = 256, BK = 64, HALF = 128, HTB = HALF * BK * 2  , STAGE_BYTES = 8 * HTB, NXCD = 8, WGM = 8;

__host__ __device__ __forceinline__ int lds_byte(int r, int c) { const int st = (r >> 4) * 2 + (c >> 5), rr = r & 15, cc = c & 31, ob = rr * 64 + cc * 2; return st * 1024 + (ob ^ (((ob >> 9) & 1) << 5)); }
__host__ __device__ __forceinline__ void stage_rc(int b, int& R, int& C) { const int st = b / 1024, sb = b % 1024, swz = sb ^ (((sb >> 9) & 1) << 5); R = (st >> 1) * 16 + swz / 64; C = (st & 1) * 32 + (swz % 64) / 2; }
__host__ __device__ __forceinline__ int perm32(int rho) { const int n = rho >> 4, i = rho & 15; return 8 * (i >> 2) + 4 * n + (i & 3); }

struct Unit { int pm, pn; };
struct Gemm { const bf16_t* A; const bf16_t* Bt; int M, N, K; };

struct StaticOrder {
    int nM, nN, nwg, G, c;
    __host__ __device__ void init(int M, int N, int G_, int c_) { nM = M / BM; nN = N / BM; nwg = nM * nN; G = G_; c = c_; }
    __host__ __device__ bool next(int i, Unit& u) const {
        const long L = (long)i * G + c; if (L >= nwg) return false;
        int wgid = (int)L; { const int q = nwg / NXCD, r = nwg % NXCD, xcd = wgid % NXCD, off = wgid / NXCD; wgid = (xcd < r ? xcd * (q + 1) : r * (q + 1) + (xcd - r) * q) + off; }
        const int nig = WGM * nN, gid = wgid / nig, fm = gid * WGM, gsz = (nM - fm) < WGM ? (nM - fm) : WGM;
        u.pm = fm + ((wgid % nig) % gsz); u.pn = (wgid % nig) / gsz; return true;
    }
    __device__ __forceinline__ void a_ready(const Unit&) const {}
    __device__ __forceinline__ void done(const Unit&) const {}
};

__device__ __forceinline__ unsigned cvt_pk_bf16(float lo, float hi) { unsigned r; asm volatile("v_cvt_pk_bf16_f32 %0, %1, %2" : "=v"(r) : "v"(lo), "v"(hi)); return r; }
typedef float f32x2 __attribute__((ext_vector_type(2)));
struct EpiBf16 {
    static constexpr bool PERM = true, AFTER_DRAIN = false;
    bf16_t* O; int ldc;
    __device__ __forceinline__ void operator()(const f32x4 (&acc)[2][2][4][2], const Unit& u, int wr, int wc, int fr, int fq) const {
        const int row0 = u.pm * BM + wr * 64 + fr; const int col0 = u.pn * BM + wc * 32 + 8 * fq;
#pragma unroll
        for (int ai = 0; ai < 2; ++ai)
#pragma unroll
            for (int m = 0; m < 4; ++m) { bf16_t* rowp = O + (size_t)(row0 + ai * HALF + m * 16) * ldc + col0;
#pragma unroll
                for (int bj = 0; bj < 2; ++bj) { const f32x4 v0 = acc[ai][bj][m][0], v1 = acc[ai][bj][m][1];
                    u32x4 w; w.x = cvt_pk_bf16(v0[0], v0[1]); w.y = cvt_pk_bf16(v0[2], v0[3]); w.z = cvt_pk_bf16(v1[0], v1[1]); w.w = cvt_pk_bf16(v1[2], v1[3]);
                    *(u32x4*)(rowp + bj * HALF) = w; } }
    }
};
__device__ __forceinline__ float silu_mul(float g, float u) { const float e = __expf(-g); return g * u * __builtin_amdgcn_rcpf(1.0f + e); }
struct EpiSwiglu {
    static constexpr bool PERM = true, AFTER_DRAIN = false;
    bf16_t* O; int ldc;
    __device__ __forceinline__ void operator()(const f32x4 (&acc)[2][2][4][2], const Unit& u, int wr, int wc, int fr, int fq) const {
        const int row0 = u.pm * BM + wr * 64 + fr; const int col0 = u.pn * HALF + wc * 32 + 8 * fq;
#pragma unroll
        for (int ai = 0; ai < 2; ++ai)
#pragma unroll
            for (int m = 0; m < 4; ++m) { bf16_t* rowp = O + (size_t)(row0 + ai * HALF + m * 16) * ldc + col0;
                const f32x4 g0 = acc[ai][0][m][0], g1 = acc[ai][0][m][1], u0 = acc[ai][1][m][0], u1 = acc[ai][1][m][1];
                u32x4 w;
                w.x = cvt_pk_bf16(silu_mul(g0[0], u0[0]), silu_mul(g0[1], u0[1])); w.y = cvt_pk_bf16(silu_mul(g0[2], u0[2]), silu_mul(g0[3], u0[3]));
                w.z = cvt_pk_bf16(silu_mul(g1[0], u1[0]), silu_mul(g1[1], u1[1])); w.w = cvt_pk_bf16(silu_mul(g1[2], u1[2]), silu_mul(g1[3], u1[3]));
                *(u32x4*)rowp = w; }
    }
};
template <class Epi, class Sched, bool ALIGN_EPI = false, bool SP2 = false>
__device__ __forceinline__ void gemm_phase(PG8_LAS unsigned char* lds, const Gemm g, const Sched& S, const Epi& E) {
    const int tid = threadIdx.x, wid = __builtin_amdgcn_readfirstlane(tid >> 6), lane = tid & 63, wr = wid >> 2, wc = wid & 3, fr = lane & 15, fq = lane >> 4;
    const int K = g.K, nt = K / BK;
    unsigned voffA[2], voffB[2];
#pragma unroll
    for (int i = 0; i < 2; ++i) { int R, C; stage_rc(tid * 16 + i * 8192, R, C); const int Rb = Epi::PERM ? ((R & ~31) + perm32(R & 31)) : R;
        voffA[i] = (unsigned)(R * K + C) * 2u; voffB[i] = (unsigned)(Rb * K + C) * 2u; }
    const size_t kstep = (size_t)(BK * 2);
    const size_t hstep = (size_t)HALF * K * 2;
    const size_t tstep = 2 * hstep;
    const unsigned ldsw = (unsigned)wid * 1024u;
    const int aoff = lds_byte(wr * 64 + fr, fq * 8), boff = lds_byte(wc * 32 + fr, fq * 8);
#define PG8_SA(b, h) (((b) * 2 + (h)) * HTB)
#define PG8_SB(b, h) ((4 + (b) * 2 + (h)) * HTB)
#define PG8_STAGE(bufoff, gbase, voff) do { _Pragma("unroll") for (int _i = 0; _i < 2; ++_i) \
        __builtin_amdgcn_global_load_lds((const unsigned*)((const char*)(gbase) + (voff)[_i]), (PG8_LAS unsigned*)(lds + (bufoff) + ldsw + _i * 8192), 16, 0, 0); } while (0)
#define PG8_LDA(dst, b, h) do { _Pragma("unroll") for (int m = 0; m < 4; ++m) _Pragma("unroll") for (int k = 0; k < 2; ++k) dst[m][k] = *(const PG8_LAS bf16x8*)(lds + PG8_SA(b, h) + aoff + m * 2048 + k * 1024); } while (0)
#define PG8_LDB(dst, b, h) do { _Pragma("unroll") for (int n = 0; n < 2; ++n) _Pragma("unroll") for (int k = 0; k < 2; ++k) dst[n][k] = *(const PG8_LAS bf16x8*)(lds + PG8_SB(b, h) + boff + n * 2048 + k * 1024); } while (0)
#define PG8_MMA(ai, bj, At, Bt) do { __builtin_amdgcn_s_setprio(1); _Pragma("unroll") for (int m = 0; m < 4; ++m) _Pragma("unroll") for (int n = 0; n < 2; ++n) _Pragma("unroll") for (int k = 0; k < 2; ++k) \
        acc[ai][bj][m][n] = __builtin_amdgcn_mfma_f32_16x16x32_bf16(Bt[n][k], At[m][k], acc[ai][bj][m][n], 0, 0, 0); __builtin_amdgcn_s_setprio(0); } while (0)
#define PG8_WAIT_V(n) asm volatile("s_waitcnt vmcnt(" #n ")" ::: "memory")
#define PG8_WAIT_L(n) asm volatile("s_waitcnt lgkmcnt(" #n ")" ::: "memory")
#define PG8_BAR __builtin_amdgcn_s_barrier()
#define PG8_SCHED __builtin_amdgcn_sched_barrier(0)
    Unit cur, nxt; int ui = 0;
    if (!S.next(0, cur)) return;
    f32x4 acc[2][2][4][2];
#pragma unroll
    for (int a = 0; a < 2; ++a)
#pragma unroll
        for (int b = 0; b < 2; ++b)
#pragma unroll
            for (int m = 0; m < 4; ++m)
#pragma unroll
                for (int n = 0; n < 2; ++n) acc[a][b][m][n] = (f32x4){0.f, 0.f, 0.f, 0.f};
    bf16x8 At[4][2], B0[2][2], B1[2][2];
    const char* cA = (const char*)g.A + (size_t)cur.pm * tstep; const char* cB = (const char*)g.Bt + (size_t)cur.pn * tstep;
    S.a_ready(cur);
    if constexpr (SP2) {
        PG8_STAGE(PG8_SB(0, 0), cB, voffB); PG8_STAGE(PG8_SB(0, 1), cB + hstep, voffB); PG8_STAGE(PG8_SA(0, 0), cA, voffA); PG8_STAGE(PG8_SA(0, 1), cA + hstep, voffA);
        if (wr == 1) PG8_BAR;
        PG8_WAIT_V(2); PG8_BAR;
        PG8_STAGE(PG8_SB(1, 0), cB + kstep, voffB); PG8_STAGE(PG8_SA(1, 0), cA + kstep, voffA); PG8_STAGE(PG8_SB(1, 1), cB + hstep + kstep, voffB);
        PG8_WAIT_V(6); PG8_BAR;
    } else {
        PG8_STAGE(PG8_SB(0, 0), cB, voffB); PG8_STAGE(PG8_SA(0, 0), cA, voffA); PG8_STAGE(PG8_SB(0, 1), cB + hstep, voffB); PG8_STAGE(PG8_SA(0, 1), cA + hstep, voffA);
        if (wr == 1) PG8_BAR;
        PG8_WAIT_V(4); PG8_BAR;
        PG8_STAGE(PG8_SB(1, 0), cB + kstep, voffB); PG8_STAGE(PG8_SA(1, 0), cA + kstep, voffA); PG8_STAGE(PG8_SB(1, 1), cB + hstep + kstep, voffB);
        PG8_WAIT_V(6); PG8_BAR;
    }
    for (;;) {
        const bool has_next = S.next(ui + 1, nxt);
        const char* nA = has_next ? (const char*)g.A + (size_t)nxt.pm * tstep : cA; const char* nB = has_next ? (const char*)g.Bt + (size_t)nxt.pn * tstep : cB;
        for (int t = 0; t < nt; t += 2) {
            const bool last = (t == nt - 2);
            const char* a1 = cA + (size_t)(t + 1) * kstep;
            const char* a2 = last ? nA : cA + (size_t)(t + 2) * kstep; const char* b2 = last ? nB : cB + (size_t)(t + 2) * kstep;
            const char* a3 = a2 + kstep; const char* b3 = b2 + kstep;
            if (last && has_next) S.a_ready(nxt);
            if constexpr (SP2) {
            PG8_LDB(B0, 0, 0); PG8_LDB(B1, 0, 1); PG8_SCHED; PG8_LDA(At, 0, 0); PG8_STAGE(PG8_SA(1, 1), a1 + hstep, voffA);
            PG8_WAIT_V(8); PG8_WAIT_L(0); PG8_BAR; PG8_MMA(0, 0, At, B0); PG8_MMA(0, 1, At, B1); PG8_BAR; PG8_SCHED;
            PG8_LDA(At, 0, 1); PG8_STAGE(PG8_SB(0, 0), b2, voffB); PG8_STAGE(PG8_SB(0, 1), b2 + hstep, voffB); PG8_STAGE(PG8_SA(0, 0), a2, voffA);
            PG8_WAIT_V(8); PG8_WAIT_L(0); PG8_BAR; PG8_MMA(1, 0, At, B0); PG8_MMA(1, 1, At, B1); PG8_BAR; PG8_SCHED;
            PG8_LDB(B0, 1, 0); PG8_LDB(B1, 1, 1); PG8_SCHED; PG8_LDA(At, 1, 0); PG8_STAGE(PG8_SA(0, 1), a2 + hstep, voffA);
            PG8_WAIT_V(8); PG8_WAIT_L(0); PG8_BAR; PG8_MMA(0, 0, At, B0); PG8_MMA(0, 1, At, B1); PG8_BAR; PG8_SCHED;
            PG8_LDA(At, 1, 1); PG8_STAGE(PG8_SB(1, 0), b3, voffB); PG8_STAGE(PG8_SB(1, 1), b3 + hstep, voffB); PG8_STAGE(PG8_SA(1, 0), a3, voffA);
            PG8_WAIT_V(8); PG8_WAIT_L(0); PG8_BAR; PG8_MMA(1, 0, At, B0); PG8_MMA(1, 1, At, B1); PG8_BAR; PG8_SCHED;
            } else {
            PG8_LDB(B0, 0, 0); PG8_SCHED; PG8_LDA(At, 0, 0); PG8_STAGE(PG8_SA(1, 1), a1 + hstep, voffA);
            PG8_WAIT_L(8); PG8_BAR; PG8_WAIT_L(0); PG8_MMA(0, 0, At, B0); PG8_BAR; PG8_SCHED;
            PG8_LDB(B1, 0, 1); PG8_STAGE(PG8_SB(0, 0), b2, voffB);
            PG8_BAR; PG8_WAIT_L(0); PG8_MMA(0, 1, At, B1); PG8_BAR;
            PG8_LDA(At, 0, 1); PG8_STAGE(PG8_SA(0, 0), a2, voffA);
            PG8_BAR; PG8_WAIT_L(0); PG8_MMA(1, 0, At, B0); PG8_BAR; PG8_SCHED;
            PG8_STAGE(PG8_SB(0, 1), b2 + hstep, voffB);
            PG8_WAIT_V(6); PG8_BAR; PG8_MMA(1, 1, At, B1); PG8_BAR;
            PG8_LDB(B0, 1, 0); PG8_SCHED; PG8_LDA(At, 1, 0); PG8_STAGE(PG8_SA(0, 1), a2 + hstep, voffA);
            PG8_WAIT_L(8); PG8_BAR; PG8_WAIT_L(0); PG8_MMA(0, 0, At, B0); PG8_BAR; PG8_SCHED;
            PG8_LDB(B1, 1, 1); PG8_STAGE(PG8_SB(1, 0), b3, voffB);
            PG8_BAR; PG8_WAIT_L(0); PG8_MMA(0, 1, At, B1); PG8_BAR;
            PG8_LDA(At, 1, 1); PG8_STAGE(PG8_SA(1, 0), a3, voffA);
            PG8_BAR; PG8_WAIT_L(0); PG8_MMA(1, 0, At, B0); PG8_BAR; PG8_SCHED;
            PG8_STAGE(PG8_SB(1, 1), b3 + hstep, voffB);
            PG8_WAIT_V(6); PG8_BAR; PG8_MMA(1, 1, At, B1); PG8_BAR;
            }
        }
        if constexpr (ALIGN_EPI) { if (wr == 0) PG8_BAR; }
        if constexpr (!Epi::AFTER_DRAIN) { E(acc, cur, wr, wc, fr, fq); S.done(cur); }
        if (!has_next) break;
#pragma unroll
        for (int a = 0; a < 2; ++a)
#pragma unroll
            for (int b = 0; b < 2; ++b)
#pragma unroll
                for (int m = 0; m < 4; ++m)
#pragma unroll
                    for (int n = 0; n < 2; ++n) acc[a][b][m][n] = (f32x4){0.f, 0.f, 0.f, 0.f};
        cur = nxt; cA = nA; cB = nB; ++ui;
        if constexpr (ALIGN_EPI) { if (wr == 1) PG8_BAR; }
    }
    PG8_WAIT_V(0);
    if constexpr (!ALIGN_EPI) { if (wr == 0) PG8_BAR; }
    PG8_BAR;
    if constexpr (Epi::AFTER_DRAIN) { E.fused(acc, cur, wr, wc, fr, fq, lds, wid, lane); S.done(cur); }
#undef PG8_SA
#undef PG8_SB
#undef PG8_STAGE
#undef PG8_LDA
#undef PG8_LDB
#undef PG8_MMA
#undef PG8_WAIT_V
#undef PG8_WAIT_L
#undef PG8_BAR
#undef PG8_SCHED
}
}

constexpr int NWAVES = 8, NTHR = NWAVES * 64;
constexpr int BATCH = 4, SEQ = 4096, D = 1024, FF = 2816, M = BATCH * SEQ;
constexpr int NZ = 3072, WINC = 3088;
constexpr int NH = 4, DK = 64, DV = 128, CH = 128, NC = SEQ / CH;
constexpr int Z_BG = 0, Z_CG = 512, Z_HC = 1024, Z_Q = 1536, Z_K = 1792, Z_V = 2048, Z_O = 2560;
constexpr float EPS = 1e-6f, NEG_INF = -1e30f;
constexpr int N_PHASES = 13;
#ifndef REP_5
#define REP_5 1
#endif
#ifndef REP_7
#define REP_7 1
#endif
#ifndef REP_M
#define REP_M 1
#endif
#ifndef SYNC_REP
#define SYNC_REP 1
#endif
#ifndef MK_CUTS
#define MK_CUTS {0, N_PHASES}
#endif

constexpr size_t MiB = 1u << 20;
constexpr size_t WS_W1I = 1 * MiB, WS_W1O = 12 * MiB, WS_WMI = 35 * MiB / 2, WS_WMO = 47 * MiB / 2, WS_W2I = 51 * MiB / 2, WS_W2O = 73 * MiB / 2, WS_WG = 42 * MiB;
constexpr size_t WS_XN = 44 * MiB;
constexpr size_t WS_ACT = 76 * MiB;
constexpr size_t WS_H = 172 * MiB;
constexpr size_t WS_G = 204 * MiB;
constexpr size_t WS_CC = 205 * MiB;
constexpr size_t WS_CP = 237 * MiB;
constexpr size_t WS_SM = 253 * MiB;
constexpr size_t WS_END = 254 * MiB;
constexpr int LDS_BYTES = 147456;

#define GAS __attribute__((address_space(1)))
#define LAS __attribute__((address_space(3)))
typedef unsigned short bf16;
typedef unsigned v4u __attribute__((ext_vector_type(4)));
typedef unsigned v2u __attribute__((ext_vector_type(2)));
typedef float f32x4 __attribute__((ext_vector_type(4)));
typedef short bf16x8 __attribute__((ext_vector_type(8)));
#define LDS_WAIT() asm volatile("s_waitcnt lgkmcnt(0)" ::: "memory")
__device__ __forceinline__ unsigned f2bf(float f) { unsigned u = __builtin_bit_cast(unsigned, f); return (u + 0x7fffu + ((u >> 16) & 1u)) >> 16; }
__device__ __forceinline__ unsigned pk2(float lo, float hi) { return f2bf(lo) | (f2bf(hi) << 16); }
__device__ __forceinline__ float bflo(unsigned w) { return __uint_as_float(w << 16); }
__device__ __forceinline__ float bfhi(unsigned w) { return __uint_as_float(w & 0xffff0000u); }
__device__ __forceinline__ float bf2f(bf16 h) { return __uint_as_float((unsigned)h << 16); }
typedef float f32x16 __attribute__((ext_vector_type(16)));
typedef float f32x2_t __attribute__((ext_vector_type(2))); typedef __bf16 bf16x2_t __attribute__((ext_vector_type(2)));
__device__ __forceinline__ unsigned cvtpk(float lo, float hi) { f32x2_t v = {lo, hi}; bf16x2_t b = __builtin_convertvector(v, bf16x2_t); return __builtin_bit_cast(unsigned, b); }
#define MFMA32(a, b, c) __builtin_amdgcn_mfma_f32_32x32x16_bf16((a), (b), (c), 0, 0, 0)
__device__ __forceinline__ float wave_sum(float v) {
#pragma unroll
    for (int o = 1; o < 64; o <<= 1) v += __shfl_xor(v, o);
    return v;
}


__device__ __forceinline__ float lane_scan_sum(float s, int lane) {
#pragma unroll
    for (int o = 1; o < 64; o <<= 1) { const float v = __shfl_up(s, o); if (lane >= o) s += v; }
    return s;
}
__device__ __forceinline__ float lane_scan_max(float s, int lane) {
#pragma unroll
    for (int o = 1; o < 64; o <<= 1) { const float v = __shfl_up(s, o); if (lane >= o) s = fmaxf(s, v); }
    return s;
}
__device__ __forceinline__ float wave_max(float v) {
#pragma unroll
    for (int o = 1; o < 64; o <<= 1) v = fmaxf(v, __shfl_xor(v, o));
    return v;
}

__device__ __forceinline__ void transpose_item(const float* __restrict__ W, int ldw, int k0, int c0, bf16* __restrict__ WT, int K, int r0, LAS float* scr, int lane) {
#pragma unroll 8
    for (int i = 0; i < 32; ++i) { const int kk = 2 * i + (lane >> 5); scr[kk * 33 + (lane & 31)] = W[(size_t)(k0 + kk) * ldw + c0 + (lane & 31)]; }
    LDS_WAIT(); asm volatile("" ::: "memory");
    const int c = lane & 7;
#pragma unroll
    for (int j = 0; j < 4; ++j) { const int n = (lane >> 3) + 8 * j; const LAS float* s = scr + (8 * c) * 33 + n;
        v4u o; o.x = pk2(s[0 * 33], s[1 * 33]); o.y = pk2(s[2 * 33], s[3 * 33]); o.z = pk2(s[4 * 33], s[5 * 33]); o.w = pk2(s[6 * 33], s[7 * 33]);
        *(v4u*)(WT + (size_t)(r0 + n) * K + k0 + 8 * c) = o; }
    LDS_WAIT(); asm volatile("" ::: "memory");
}
__device__ __forceinline__ int swiglu_row(int c0) { const int s = c0 / FF, j = c0 % FF; return 256 * (j / 128) + 128 * s + (j % 128); }

template <bool HAS_H, bool HAS_NEXT>
__device__ __forceinline__ void norm_rows(const float* xin, const bf16* H, const float* gpost, float scale, float* xout, const float* gpre, bf16* XN, int gw, int NGW, int lane) {
    f32x4 gp[4], gn[4];
#pragma unroll
    for (int j = 0; j < 4; ++j) { if (HAS_H) gp[j] = ((const f32x4*)gpost)[lane + 64 * j]; if (HAS_NEXT) gn[j] = ((const f32x4*)gpre)[lane + 64 * j]; }
    for (int m = gw; m < M; m += NGW) {
        f32x4 v[4];
#pragma unroll
        for (int j = 0; j < 4; ++j) v[j] = ((const f32x4*)(xin + (size_t)m * D))[lane + 64 * j];
        if (HAS_H) {
            f32x4 hv[4]; float s = 0.f;
#pragma unroll
            for (int j = 0; j < 4; ++j) { const v2u w = ((const v2u*)(H + (size_t)m * D))[lane + 64 * j]; hv[j] = (f32x4){bflo(w.x), bfhi(w.x), bflo(w.y), bfhi(w.y)};
                s += (hv[j].x * hv[j].x + hv[j].y * hv[j].y) + (hv[j].z * hv[j].z + hv[j].w * hv[j].w); }
            const float rh = scale / sqrtf(wave_sum(s) * (1.f / D) + EPS);
#pragma unroll
            for (int j = 0; j < 4; ++j) { v[j] = v[j] + hv[j] * gp[j] * rh; ((f32x4*)(xout + (size_t)m * D))[lane + 64 * j] = v[j]; }
        }
        if (HAS_NEXT) {
            float s = 0.f;
#pragma unroll
            for (int j = 0; j < 4; ++j) s += (v[j].x * v[j].x + v[j].y * v[j].y) + (v[j].z * v[j].z + v[j].w * v[j].w);
            const float r = 1.0f / sqrtf(wave_sum(s) * (1.f / D) + EPS);
#pragma unroll
            for (int j = 0; j < 4; ++j) { const f32x4 o = v[j] * gn[j] * r; v2u w; w.x = pk2(o.x, o.y); w.y = pk2(o.z, o.w); ((v2u*)(XN + (size_t)m * D))[lane + 64 * j] = w; }
        }
    }
}

__device__ __forceinline__ void ld8(const bf16* p, float (&o)[8]) { const v4u w = *(const v4u*)p; o[0] = bflo(w.x); o[1] = bfhi(w.x); o[2] = bflo(w.y); o[3] = bfhi(w.y); o[4] = bflo(w.z); o[5] = bfhi(w.z); o[6] = bflo(w.w); o[7] = bfhi(w.w); }

struct Args { const float* in[18]; float* out; unsigned char* ws; int ph_lo, ph_hi; };
__global__ void __launch_bounds__(NTHR, 2) fwd(Args args) {
    extern __shared__ __attribute__((aligned(16))) unsigned char lds_raw[];
    LAS unsigned char* lds = (LAS unsigned char*)lds_raw;
    cg::grid_group grid = cg::this_grid();
    const int tid = threadIdx.x, lane = tid & 63, wave = __builtin_amdgcn_readfirstlane(tid >> 6);
    const int G = gridDim.x, gw = blockIdx.x * NWAVES + wave, NGW = G * NWAVES;
    unsigned char* ws = args.ws;
    const float* x = args.in[0]; float* out = args.out;
    bf16* W1I = (bf16*)(ws + WS_W1I); bf16* W1O = (bf16*)(ws + WS_W1O); bf16* WMI = (bf16*)(ws + WS_WMI); bf16* WMO = (bf16*)(ws + WS_WMO);
    bf16* W2I = (bf16*)(ws + WS_W2I); bf16* W2O = (bf16*)(ws + WS_W2O); bf16* WGT = (bf16*)(ws + WS_WG);
    bf16* XN = (bf16*)(ws + WS_XN); bf16* Y = XN; bf16* ACT = (bf16*)(ws + WS_ACT); bf16* Z = ACT; bf16* H = (bf16*)(ws + WS_H);
    float* Gt = (float*)(ws + WS_G); float* CC = (float*)(ws + WS_CC); bf16* CP = (bf16*)(ws + WS_CP);
    float* NCc = (float*)(ws + WS_SM); float* NPp = NCc + 1024 * 64; float* GC = NPp + 1024 * 64; float* MC = GC + 1024; float* MP = MC + 1024;
    const int lo = args.ph_lo, hi = args.ph_hi;
#define IN(k) (lo <= (k) && (k) < hi)
#define SEAM(k) do { if (IN(k) && IN((k) + 1)) { for (int sr_ = 0; sr_ < SYNC_REP; ++sr_) grid.sync(); } } while (0)

    if (IN(0)) {
        LAS float* scr = (LAS float*)(lds + wave * 16384);
        constexpr int I_FI = 16 * 176, I_FO = 44 * 32, I_MI = 16 * 96, I_MO = 16 * 32, NITEMS = 2 * (I_FI + I_FO) + I_MI + I_MO;
        for (int it = gw; it < NITEMS; it += NGW) {
            int r = it;
            if (r < I_FI) { const int kb = r / 176, nb = r % 176; transpose_item(args.in[3], 2 * FF, 64 * kb, 32 * nb, W1I, D, swiglu_row(32 * nb), scr, lane); continue; } r -= I_FI;
            if (r < I_FI) { const int kb = r / 176, nb = r % 176; transpose_item(args.in[16], 2 * FF, 64 * kb, 32 * nb, W2I, D, swiglu_row(32 * nb), scr, lane); continue; } r -= I_FI;
            if (r < I_FO) { const int kb = r / 32, nb = r % 32; transpose_item(args.in[4], D, 64 * kb, 32 * nb, W1O, FF, 32 * nb, scr, lane); continue; } r -= I_FO;
            if (r < I_FO) { const int kb = r / 32, nb = r % 32; transpose_item(args.in[17], D, 64 * kb, 32 * nb, W2O, FF, 32 * nb, scr, lane); continue; } r -= I_FO;
            if (r < I_MI) { const int kb = r / 96, nb = r % 96; transpose_item(args.in[7], WINC, 64 * kb, 32 * nb, WMI, D, 32 * nb, scr, lane); continue; } r -= I_MI;
            { const int kb = r / 32, nb = r % 32; transpose_item(args.in[13], D, 64 * kb, 32 * nb, WMO, D, 32 * nb, scr, lane); }
        }
        for (int e = blockIdx.x * NTHR + tid; e < 16 * D; e += G * NTHR) { const int g = e / D, k = e % D; WGT[e] = (bf16)f2bf(args.in[7][(size_t)k * WINC + NZ + g]); }
        norm_rows<false, true>(x, nullptr, nullptr, 0.f, nullptr, args.in[1], XN, gw, NGW, lane);
    }
    SEAM(0);
    if (IN(1)) {
        pg8::Gemm g{XN, W1I, M, 2 * FF, D}; pg8::StaticOrder S; S.init(M, 2 * FF, G, (int)blockIdx.x);
        pg8::EpiSwiglu E{ACT, FF};
        pg8::gemm_phase<pg8::EpiSwiglu, pg8::StaticOrder, true, true>(lds, g, S, E);
    }
    SEAM(1);
    if (IN(2)) {
        pg8::Gemm g{ACT, W1O, M, D, FF}; pg8::StaticOrder S; S.init(M, D, G, (int)blockIdx.x);
        pg8::EpiBf16 E{H, D};
        pg8::gemm_phase<pg8::EpiBf16, pg8::StaticOrder, true, true>(lds, g, S, E);
    }
    SEAM(2);
    if (IN(3)) norm_rows<true, true>(x, H, args.in[2], 0.5f, out, args.in[5], XN, gw, NGW, lane);
    SEAM(3);
    if (IN(4)) {
        const int fr = lane & 15, fq = lane >> 4;
        for (int rb = gw; rb < M / 16; rb += NGW) {
            f32x4 acc = {0.f, 0.f, 0.f, 0.f};
            const bf16* arow = XN + (size_t)(rb * 16 + fr) * D + fq * 8; const bf16* brow = WGT + (size_t)fr * D + fq * 8;
#pragma unroll 8
            for (int kk = 0; kk < D / 32; ++kk) { const bf16x8 a = *(const bf16x8*)(arow + kk * 32); const bf16x8 b = *(const bf16x8*)(brow + kk * 32);
                acc = __builtin_amdgcn_mfma_f32_16x16x32_bf16(b, a, acc, 0, 0, 0); }
            f32x4 o;
#pragma unroll
            for (int i = 0; i < 4; ++i) { const int gcol = 4 * fq + i;
                if (gcol < 8) o[i] = acc[i] + args.in[10][gcol];
                else { const float v = acc[i] + args.in[11][gcol - 8]; o[i] = fminf(v, 0.f) - log1pf(__expf(-fabsf(v))); } }
            *(f32x4*)(Gt + (size_t)(rb * 16 + fr) * 16 + 4 * fq) = o;
        }
        pg8::Gemm g{XN, WMI, M, NZ, D}; pg8::StaticOrder S; S.init(M, NZ, G, (int)blockIdx.x);
        pg8::EpiBf16 E{Z, NZ};
        pg8::gemm_phase<pg8::EpiBf16, pg8::StaticOrder, true, true>(lds, g, S, E);
    }
    SEAM(4);
    for (int rep_m = 0; rep_m < REP_M; ++rep_m) {
    for (int rep5 = 0; rep5 < REP_5; ++rep5)
    if (IN(5)) {
        {
        constexpr int VP = 132;
        LAS bf16* VTs = (LAS bf16*)lds; LAS bf16* KeT = VTs + DV * VP;
        LAS float* ev = (LAS float*)(KeT + 2 * DK * VP);
        const int l31 = lane & 31, hh = lane >> 5, d = wave >> 2, dvb = wave & 3;
        for (int it2 = blockIdx.x; it2 < BATCH * NH * NC; it2 += G) {
            const int b = it2 >> 7, h = (it2 >> 5) & 3, c = it2 & 31, r0 = b * SEQ + c * CH;
            __syncthreads();
#pragma unroll
            for (int j = 0; j < 4; ++j) { const int e = tid + NTHR * j, sr = e & 127, c16 = e >> 7;
                const v4u w = *(const v4u*)(Z + (size_t)(r0 + sr) * NZ + Z_V + h * DV + c16 * 8); LAS bf16* vp = VTs + (c16 * 8) * VP + sr;
                vp[0 * VP] = (bf16)(w.x & 0xffffu); vp[1 * VP] = (bf16)(w.x >> 16); vp[2 * VP] = (bf16)(w.y & 0xffffu); vp[3 * VP] = (bf16)(w.y >> 16);
                vp[4 * VP] = (bf16)(w.z & 0xffffu); vp[5 * VP] = (bf16)(w.z >> 16); vp[6 * VP] = (bf16)(w.w & 0xffffu); vp[7 * VP] = (bf16)(w.w >> 16); }
            if (wave < 2) {
                const int gd = wave, itg = ((gd * BATCH + b) * NH + h) * NC + c;
                const int t0 = gd ? 127 - 2 * lane : 2 * lane, t1 = gd ? 126 - 2 * lane : 2 * lane + 1;
                const float lf0 = Gt[(size_t)(r0 + t0) * 16 + 8 + gd * 4 + h], lf1 = Gt[(size_t)(r0 + t1) * 16 + 8 + gd * 4 + h];
                const float li0 = Gt[(size_t)(r0 + t0) * 16 + gd * 4 + h], li1 = Gt[(size_t)(r0 + t1) * 16 + gd * 4 + h];
                const float tot = lf0 + lf1, incl = lane_scan_sum(tot, lane), b0 = incl - tot + lf0, b1 = b0 + lf1;
                const float gsum = __shfl(incl, 63);
                const float w0 = gsum - b0 + li0, w1 = gsum - b1 + li1, mx = wave_max(fmaxf(w0, w1));
                ev[gd * CH + t0] = __expf(w0 - mx); ev[gd * CH + t1] = __expf(w1 - mx);
                if (lane == 0) { GC[itg] = gsum; MC[itg] = mx; }
            }
            __syncthreads();
#pragma unroll
            for (int j = 0; j < 2; ++j) { const int e = tid + NTHR * j, tr = e & 127, c8 = e >> 7; float f[8]; ld8(Z + (size_t)(r0 + tr) * NZ + Z_K + h * DK + c8 * 8, f);
                const float e0 = ev[tr], e1 = ev[CH + tr]; LAS bf16* kp = KeT + (c8 * 8) * VP + tr;
#pragma unroll
                for (int i = 0; i < 8; ++i) { kp[i * VP] = (bf16)f2bf(f[i] * e0); kp[(DK + i) * VP] = (bf16)f2bf(f[i] * e1); } }
            __syncthreads();
            const int it = ((d * BATCH + b) * NH + h) * NC + c;
            f32x16 acc[2];
#pragma unroll
            for (int nt = 0; nt < 2; ++nt)
#pragma unroll
                for (int i = 0; i < 16; ++i) acc[nt][i] = 0.f;
#pragma unroll
            for (int ks = 0; ks < 8; ++ks) { const LAS bf16* ap = VTs + (32 * dvb + l31) * VP + 16 * ks + 8 * hh;
                const v2u a0 = *(const LAS v2u*)ap, a1 = *(const LAS v2u*)(ap + 4); v4u aw; aw.x = a0.x; aw.y = a0.y; aw.z = a1.x; aw.w = a1.y;
#pragma unroll
                for (int nt = 0; nt < 2; ++nt) { const LAS bf16* bp = KeT + (d * DK + 32 * nt + l31) * VP + 16 * ks + 8 * hh;
                    const v2u b0 = *(const LAS v2u*)bp, b1 = *(const LAS v2u*)(bp + 4); v4u bw; bw.x = b0.x; bw.y = b0.y; bw.z = b1.x; bw.w = b1.y;
                    acc[nt] = MFMA32(__builtin_bit_cast(bf16x8, aw), __builtin_bit_cast(bf16x8, bw), acc[nt]); } }
#pragma unroll
            for (int nt = 0; nt < 2; ++nt)
#pragma unroll
                for (int i = 0; i < 16; ++i) CC[(size_t)it * (DV * DK) + (32 * dvb + (i & 3) + 8 * (i >> 2) + 4 * hh) * DK + 32 * nt + l31] = acc[nt][i];
            if (tid < 2 * DK) { const int nd = tid >> 6, ndk = tid & 63; const LAS bf16* kp = KeT + (nd * DK + ndk) * VP; float n = 0.f;
#pragma unroll
                for (int i = 0; i < 32; ++i) { const v2u w = *(const LAS v2u*)(kp + 4 * i); n += (bflo(w.x) + bfhi(w.x)) + (bflo(w.y) + bfhi(w.y)); }
                NCc[(((nd * BATCH + b) * NH + h) * NC + c) * DK + ndk] = n; }
        }
        }
        const float* cw = args.in[8]; const float* cb = args.in[9];
        for (int rb = blockIdx.x; rb < M / 64; rb += G) {
            const int c0 = (tid & 63) * 8, rsub = tid >> 6;
            float w0[8], w1[8], w2[8], bb[8];
#pragma unroll
            for (int i = 0; i < 8; ++i) { w0[i] = cw[c0 + i]; w1[i] = cw[512 + c0 + i]; w2[i] = cw[1024 + c0 + i]; bb[i] = cb[c0 + i]; }
            for (int p = 0; p < 8; ++p) {
                const int row = rb * 64 + p * 8 + rsub, t = row & (SEQ - 1);
                float a[8], bq[8], um[8], u0[8], up[8], bg[8];
                ld8(Z + (size_t)row * NZ + Z_CG + c0, a); ld8(Z + (size_t)row * NZ + Z_HC + c0, bq);
#pragma unroll
                for (int i = 0; i < 8; ++i) u0[i] = a[i] * bq[i];
                if (t > 0) { ld8(Z + (size_t)(row - 1) * NZ + Z_CG + c0, a); ld8(Z + (size_t)(row - 1) * NZ + Z_HC + c0, bq);
#pragma unroll
                    for (int i = 0; i < 8; ++i) um[i] = a[i] * bq[i]; }
                else {
#pragma unroll
                    for (int i = 0; i < 8; ++i) um[i] = 0.f; }
                if (t < SEQ - 1) { ld8(Z + (size_t)(row + 1) * NZ + Z_CG + c0, a); ld8(Z + (size_t)(row + 1) * NZ + Z_HC + c0, bq);
#pragma unroll
                    for (int i = 0; i < 8; ++i) up[i] = a[i] * bq[i]; }
                else {
#pragma unroll
                    for (int i = 0; i < 8; ++i) up[i] = 0.f; }
                ld8(Z + (size_t)row * NZ + Z_BG + c0, bg);
                float y[8];
#pragma unroll
                for (int i = 0; i < 8; ++i) y[i] = bg[i] * (w0[i] * um[i] + w1[i] * u0[i] + w2[i] * up[i] + bb[i]);
                v4u o; o.x = pk2(y[0], y[1]); o.y = pk2(y[2], y[3]); o.z = pk2(y[4], y[5]); o.w = pk2(y[6], y[7]);
                *(v4u*)(Y + (size_t)row * D + c0) = o;
            }
        }
    }
    SEAM(5);
    if (IN(6)) {
        LAS float* sa = (LAS float*)lds; LAS float* ss = sa + 128;
        for (int unit = blockIdx.x; unit < 256; unit += G) {
            const int seq = unit >> 3, part = unit & 7, dir = seq >> 4;
            const int e0 = part * 1024 + 2 * tid;
            const bool nthr = (part == 0 && tid < DK);
            __syncthreads();
            if (tid < NC) { const int it = seq * NC + (dir ? NC - 1 - tid : tid); sa[64 + tid] = GC[it]; ss[64 + tid] = MC[it]; }
            float2 cc[NC]; float ncv[NC];
#pragma unroll
            for (int ci = 0; ci < NC; ++ci) { const int it = seq * NC + (dir ? NC - 1 - ci : ci); cc[ci] = *(const float2*)(CC + (size_t)it * (DV * DK) + e0); ncv[ci] = nthr ? NCc[it * DK + tid] : 0.f; }
            __syncthreads();
            if (tid == 0) { float m = NEG_INF;
                for (int ci = 0; ci < NC; ++ci) { const int it = seq * NC + (dir ? NC - 1 - ci : ci);
                    if (part == 0) MP[it] = m;
                    const float gcv = sa[64 + ci], mcv = ss[64 + ci], mn = fmaxf(gcv + m, mcv);
                    sa[ci] = __expf(gcv + m - mn); ss[ci] = __expf(mcv - mn); m = mn; } }
            __syncthreads();
            float c0 = 0.f, c1 = 0.f, n = 0.f;
#pragma unroll
            for (int ci = 0; ci < NC; ++ci) { const int it = seq * NC + (dir ? NC - 1 - ci : ci);
                *(unsigned*)(CP + (size_t)it * (DV * DK) + e0) = pk2(c0, c1);
                const float a = sa[ci], sc = ss[ci];
                c0 = a * c0 + sc * cc[ci].x; c1 = a * c1 + sc * cc[ci].y;
                if (nthr) { NPp[it * DK + tid] = n; n = a * n + sc * ncv[ci]; } }
        }
    }
    SEAM(6);
    for (int rep7 = 0; rep7 < REP_7; ++rep7)
    if (IN(7)) {
        constexpr int QP = 72, VP = 132, HP = 132;
        LAS bf16* Qs = (LAS bf16*)lds; LAS bf16* Ks = Qs + CH * QP; LAS bf16* VTs = Ks + CH * QP;
        LAS float* gv = (LAS float*)(VTs + DV * VP);
        LAS float* HB = gv + 2 * 6 * CH;
        const float* hgain = args.in[12];
        const int l31 = lane & 31, hh = lane >> 5, d = wave >> 2, rb = wave & 3;
        for (int it2 = blockIdx.x; it2 < BATCH * NH * NC; it2 += G) {
            const int b = it2 >> 7, h = (it2 >> 5) & 3, c = it2 & 31, r0 = b * SEQ + c * CH;
            __syncthreads();
#pragma unroll
            for (int j = 0; j < 2; ++j) { const int e = tid + NTHR * j, row = e >> 3, c8 = e & 7;
                const v4u wq = *(const v4u*)(Z + (size_t)(r0 + row) * NZ + Z_Q + h * DK + c8 * 8); v4u o;
                o.x = pk2(bflo(wq.x) * 0.125f, bfhi(wq.x) * 0.125f); o.y = pk2(bflo(wq.y) * 0.125f, bfhi(wq.y) * 0.125f); o.z = pk2(bflo(wq.z) * 0.125f, bfhi(wq.z) * 0.125f); o.w = pk2(bflo(wq.w) * 0.125f, bfhi(wq.w) * 0.125f);
                *(LAS v4u*)(Qs + row * QP + c8 * 8) = o;
                *(LAS v4u*)(Ks + row * QP + c8 * 8) = *(const v4u*)(Z + (size_t)(r0 + row) * NZ + Z_K + h * DK + c8 * 8); }
#pragma unroll
            for (int j = 0; j < 4; ++j) { const int e = tid + NTHR * j, sr = e & 127, c16 = e >> 7;
                const v4u w = *(const v4u*)(Z + (size_t)(r0 + sr) * NZ + Z_V + h * DV + c16 * 8); LAS bf16* vp = VTs + (c16 * 8) * VP + sr;
                vp[0 * VP] = (bf16)(w.x & 0xffffu); vp[1 * VP] = (bf16)(w.x >> 16); vp[2 * VP] = (bf16)(w.y & 0xffffu); vp[3 * VP] = (bf16)(w.y >> 16);
                vp[4 * VP] = (bf16)(w.z & 0xffffu); vp[5 * VP] = (bf16)(w.z >> 16); vp[6 * VP] = (bf16)(w.w & 0xffffu); vp[7 * VP] = (bf16)(w.w >> 16); }
            if (wave < 2) {
                const int gd = wave, itg = ((gd * BATCH + b) * NH + h) * NC + c;
                const int t0 = gd ? 127 - 2 * lane : 2 * lane, t1 = gd ? 126 - 2 * lane : 2 * lane + 1;
                const float lf0 = Gt[(size_t)(r0 + t0) * 16 + 8 + gd * 4 + h], lf1 = Gt[(size_t)(r0 + t1) * 16 + 8 + gd * 4 + h];
                const float li0 = Gt[(size_t)(r0 + t0) * 16 + gd * 4 + h], li1 = Gt[(size_t)(r0 + t1) * 16 + gd * 4 + h];
                const float mprev = MP[itg];
                const float tot = lf0 + lf1, incl = lane_scan_sum(tot, lane), b0 = incl - tot + lf0, b1 = b0 + lf1;
                const float be0 = li0 - b0, be1 = li1 - b1, mloc = fmaxf(be0, be1), minc = lane_scan_max(mloc, lane);
                float mex = __shfl_up(minc, 1); if (lane == 0) mex = -3.0e38f;
                const float c0 = fmaxf(mex, be0), c1 = fmaxf(c0, be1);
                const float mt0 = fmaxf(b0 + mprev, b0 + c0), mt1 = fmaxf(b1 + mprev, b1 + c1);
                LAS float* g6 = gv + gd * 6 * CH;
                g6[1 * CH + t0] = be0; g6[1 * CH + t1] = be1;
                g6[2 * CH + t0] = b0 - mt0; g6[2 * CH + t1] = b1 - mt1;
                g6[3 * CH + t0] = __expf(b0 + mprev - mt0); g6[3 * CH + t1] = __expf(b1 + mprev - mt1);
                g6[4 * CH + t0] = __expf(-mt0); g6[4 * CH + t1] = __expf(-mt1);
            }
            __syncthreads();
            const int it = ((d * BATCH + b) * NH + h) * NC + c;
            const LAS float* gvd = gv + d * 6 * CH;
            bf16x8 qf[4];
#pragma unroll
            for (int kk = 0; kk < 4; ++kk) qf[kk] = *(const LAS bf16x8*)(Qs + (32 * rb + l31) * QP + 16 * kk + 8 * hh);
            f32x16 acc[4];
#pragma unroll
            for (int nt = 0; nt < 4; ++nt) {
#pragma unroll
                for (int i = 0; i < 16; ++i) acc[nt][i] = 0.f;
#pragma unroll
                for (int kk = 0; kk < 4; ++kk) { const bf16x8 cb = *(const bf16x8*)(CP + (size_t)it * (DV * DK) + (32 * nt + l31) * DK + 16 * kk + 8 * hh); acc[nt] = MFMA32(qf[kk], cb, acc[nt]); } }
#pragma unroll
            for (int g = 0; g < 4; ++g) { const f32x4 iv = *(const LAS f32x4*)(gvd + 3 * CH + 32 * rb + 8 * g + 4 * hh);
#pragma unroll
                for (int nt = 0; nt < 4; ++nt)
#pragma unroll
                    for (int i = 0; i < 4; ++i) acc[nt][4 * g + i] *= iv[i]; }
            const float alpha_t = gvd[2 * CH + 32 * rb + l31]; float rowsum = 0.f;
#pragma unroll 1
            for (int sb = 0; sb < 4; ++sb) {
                if (d == 0 ? (sb > rb) : (sb < rb)) continue;
                f32x16 xx;
#pragma unroll
                for (int i = 0; i < 16; ++i) xx[i] = 0.f;
#pragma unroll
                for (int kk = 0; kk < 4; ++kk) { const bf16x8 kf = *(const LAS bf16x8*)(Ks + (32 * sb + l31) * QP + 16 * kk + 8 * hh); xx = MFMA32(kf, qf[kk], xx); }
                const int tl = 32 * rb + l31;
#pragma unroll
                for (int g = 0; g < 4; ++g) { const f32x4 bv = *(const LAS f32x4*)(gvd + 1 * CH + 32 * sb + 8 * g + 4 * hh);
#pragma unroll
                    for (int i = 0; i < 4; ++i) { const int sl = 32 * sb + 8 * g + 4 * hh + i; const bool valid = d == 0 ? (sl <= tl) : (sl >= tl);
                        const float p = valid ? __expf(alpha_t + bv[i]) * xx[4 * g + i] : 0.f; xx[4 * g + i] = p; rowsum += p; } }
#pragma unroll
                for (int ks = 0; ks < 2; ++ks) {
                    v4u pw; pw.x = cvtpk(xx[8 * ks + 0], xx[8 * ks + 1]); pw.y = cvtpk(xx[8 * ks + 2], xx[8 * ks + 3]); pw.z = cvtpk(xx[8 * ks + 4], xx[8 * ks + 5]); pw.w = cvtpk(xx[8 * ks + 6], xx[8 * ks + 7]);
                    const bf16x8 pa = __builtin_bit_cast(bf16x8, pw);
#pragma unroll
                    for (int nt = 0; nt < 4; ++nt) { const LAS bf16* vp = VTs + (32 * nt + l31) * VP + 32 * sb + 16 * ks + 4 * hh;
                        const v2u lo = *(const LAS v2u*)vp, hi2 = *(const LAS v2u*)(vp + 8); v4u vw; vw.x = lo.x; vw.y = lo.y; vw.z = hi2.x; vw.w = hi2.y;
                        acc[nt] = MFMA32(pa, __builtin_bit_cast(bf16x8, vw), acc[nt]); } }
            }
            rowsum += __shfl_xor(rowsum, 32);
            float qn = 0.f;
#pragma unroll
            for (int i = 0; i < 32; ++i) qn += bf2f(Qs[(32 * rb + l31) * QP + 32 * hh + i]) * NPp[it * DK + 32 * hh + i];
            qn += __shfl_xor(qn, 32);
            { const float denom = gvd[3 * CH + 32 * rb + l31] * qn + rowsum; gv[(d * 6 + 5) * CH + 32 * rb + l31] = 1.0f / fmaxf(fabsf(denom), gvd[4 * CH + 32 * rb + l31]); }
            LDS_WAIT();
#pragma unroll
            for (int g = 0; g < 4; ++g) { const f32x4 dv4 = *(const LAS f32x4*)(gvd + 5 * CH + 32 * rb + 8 * g + 4 * hh);
#pragma unroll
                for (int nt = 0; nt < 4; ++nt)
#pragma unroll
                    for (int i = 0; i < 4; ++i) acc[nt][4 * g + i] *= dv4[i]; }
            if (d == 1) {
#pragma unroll
                for (int nt = 0; nt < 4; ++nt)
#pragma unroll
                    for (int i = 0; i < 16; ++i) HB[(32 * rb + (i & 3) + 8 * (i >> 2) + 4 * hh) * HP + 32 * nt + l31] = acc[nt][i]; }
            __syncthreads();
            if (d == 0) {
#pragma unroll
                for (int nt = 0; nt < 4; ++nt)
#pragma unroll
                    for (int i = 0; i < 16; ++i) HB[(32 * rb + (i & 3) + 8 * (i >> 2) + 4 * hh) * HP + 32 * nt + l31] += acc[nt][i]; }
            __syncthreads();
            { const int t = tid >> 2, dvq = tid & 3; f32x4 hv[8]; float sq = 0.f;
#pragma unroll
                for (int j = 0; j < 8; ++j) { hv[j] = *(const LAS f32x4*)(HB + t * HP + dvq * 32 + 4 * j); sq += (hv[j].x * hv[j].x + hv[j].y * hv[j].y) + (hv[j].z * hv[j].z + hv[j].w * hv[j].w); }
                sq += __shfl_xor(sq, 1); sq += __shfl_xor(sq, 2);
                const float r = 1.0f / sqrtf(sq * (1.f / DV) + EPS);
#pragma unroll
                for (int j8 = 0; j8 < 4; ++j8) { float o[8]; ld8(Z + (size_t)(r0 + t) * NZ + Z_O + h * DV + dvq * 32 + j8 * 8, o);
                    const f32x4 g0 = *(const f32x4*)(hgain + h * DV + dvq * 32 + j8 * 8), g1 = *(const f32x4*)(hgain + h * DV + dvq * 32 + j8 * 8 + 4);
                    const f32x4 a0 = hv[2 * j8], a1 = hv[2 * j8 + 1]; float y[8];
#pragma unroll
                    for (int i = 0; i < 4; ++i) { y[i] = a0[i] * r * g0[i] / (1.0f + __expf(-o[i])); y[4 + i] = a1[i] * r * g1[i] / (1.0f + __expf(-o[4 + i])); }
                    v4u w; w.x = pk2(y[0], y[1]); w.y = pk2(y[2], y[3]); w.z = pk2(y[4], y[5]); w.w = pk2(y[6], y[7]);
                    *(v4u*)(Y + (size_t)(r0 + t) * D + 512 + h * DV + dvq * 32 + j8 * 8) = w; } }
        }
    }
    SEAM(7);
    }
    if (IN(8)) {
        pg8::Gemm g{Y, WMO, M, D, D}; pg8::StaticOrder S; S.init(M, D, G, (int)blockIdx.x);
        pg8::EpiBf16 E{H, D};
        pg8::gemm_phase<pg8::EpiBf16, pg8::StaticOrder, true, true>(lds, g, S, E);
    }
    SEAM(8);
    if (IN(9)) norm_rows<true, true>(out, H, args.in[6], 1.0f, out, args.in[14], XN, gw, NGW, lane);
    SEAM(9);
    if (IN(10)) {
        pg8::Gemm g{XN, W2I, M, 2 * FF, D}; pg8::StaticOrder S; S.init(M, 2 * FF, G, (int)blockIdx.x);
        pg8::EpiSwiglu E{ACT, FF};
        pg8::gemm_phase<pg8::EpiSwiglu, pg8::StaticOrder, true, true>(lds, g, S, E);
    }
    SEAM(10);
    if (IN(11)) {
        pg8::Gemm g{ACT, W2O, M, D, FF}; pg8::StaticOrder S; S.init(M, D, G, (int)blockIdx.x);
        pg8::EpiBf16 E{H, D};
        pg8::gemm_phase<pg8::EpiBf16, pg8::StaticOrder, true, true>(lds, g, S, E);
    }
    SEAM(11);
    if (IN(12)) norm_rows<true, false>(out, H, args.in[15], 0.5f, out, nullptr, nullptr, gw, NGW, lane);
#undef IN
#undef SEAM
}

extern "C" void kernel_launch(void* const* d_in, const int* in_sizes, int n_in, void* d_out, int out_size, void* d_ws, size_t ws_size, hipStream_t stream) {
    static int grid = 0;
    if (grid == 0) {
        if (n_in != 18 || in_sizes[0] != M * D || out_size != M * D || ws_size < WS_END) { fprintf(stderr, "kernel_launch: unexpected shapes (n_in %d, in0 %d, out %d, ws %zu)\n", n_in, n_in > 0 ? in_sizes[0] : -1, out_size, ws_size); grid = -1; return; }
        int dev = 0, cus = 0, per_cu = 0;
        if (hipGetDevice(&dev) != hipSuccess || hipDeviceGetAttribute(&cus, hipDeviceAttributeMultiprocessorCount, dev) != hipSuccess) { grid = -1; return; }
        if (hipFuncSetAttribute((const void*)fwd, hipFuncAttributeMaxDynamicSharedMemorySize, LDS_BYTES) != hipSuccess) { fprintf(stderr, "kernel_launch: hipFuncSetAttribute failed\n"); grid = -1; return; }
        if (hipOccupancyMaxActiveBlocksPerMultiprocessor(&per_cu, (const void*)fwd, NTHR, LDS_BYTES) != hipSuccess || per_cu < 1) { fprintf(stderr, "kernel_launch: occupancy query says %d blocks per CU\n", per_cu); grid = -1; return; }
        grid = cus;
    }
    if (grid < 0) return;
    Args a{};
    for (int i = 0; i < 18; ++i) a.in[i] = (const float*)d_in[i];
    a.out = (float*)d_out; a.ws = (unsigned char*)d_ws;
    const int cuts[] = MK_CUTS;
    const int ncuts = (int)(sizeof(cuts) / sizeof(cuts[0]));
    for (int li = 0; li + 1 < ncuts; ++li) {
        a.ph_lo = cuts[li]; a.ph_hi = cuts[li + 1];
        void* kargs[] = {&a};
        const hipError_t le = hipLaunchCooperativeKernel((const void*)fwd, dim3(grid), dim3(NTHR), kargs, LDS_BYTES, stream);
        if (le != hipSuccess) { fprintf(stderr, "kernel_launch: cooperative launch %d failed: %s (grid %d)\n", li, hipGetErrorString(le), grid); break; }
    }
}
```

```cpp
#include <hip/hip_runtime.h>
#include <hip/hip_cooperative_groups.h>
#include <cstdio>
#include <cstdint>
namespace cg = cooperative_groups;
namespace pg8 {
#define PG8_LAS __attribute__((address_space(3)))
typedef unsigned short bf16_t;
typedef short bf16x8 __attribute__((ext_vector_type(8)));
typedef float f32x4 __attribute__((ext_vector_type(4)));
typedef unsigned u32x4 __attribute__((ext_vector_type(4)));
constexpr int BM = 256, BK = 64, HALF = 128, HTB = HALF * BK * 2  , STAGE_BYTES = 8 * HTB, NXCD = 8, WGM = 8;

__host__ __device__ __forceinline__ int lds_byte(int r, int c) { const int st = (r >> 4) * 2 + (c >> 5), rr = r & 15, cc = c & 31, ob = rr * 64 + cc * 2; return st * 1024 + (ob ^ (((ob >> 9) & 1) << 5)); }
__host__ __device__ __forceinline__ void stage_rc(int b, int& R, int& C) { const int st = b / 1024, sb = b % 1024, swz = sb ^ (((sb >> 9) & 1) << 5); R = (st >> 1) * 16 + swz / 64; C = (st & 1) * 32 + (swz % 64) / 2; }
__host__ __device__ __forceinline__ int perm32(int rho) { const int n = rho >> 4, i = rho & 15; return 8 * (i >> 2) + 4 * n + (i & 3); }

struct Unit { int pm, pn; };
struct Gemm { const bf16_t* A; const bf16_t* Bt; int M, N, K; };

struct StaticOrder {
    int nM, nN, nwg, G, c;
    __host__ __device__ void init(int M, int N, int G_, int c_) { nM = M / BM; nN = N / BM; nwg = nM * nN; G = G_; c = c_; }
    __host__ __device__ bool next(int i, Unit& u) const {
        const long L = (long)i * G + c; if (L >= nwg) return false;
        int wgid = (int)L; { const int q = nwg / NXCD, r = nwg % NXCD, xcd = wgid % NXCD, off = wgid / NXCD; wgid = (xcd < r ? xcd * (q + 1) : r * (q + 1) + (xcd - r) * q) + off; }
        const int nig = WGM * nN, gid = wgid / nig, fm = gid * WGM, gsz = (nM - fm) < WGM ? (nM - fm) : WGM;
        u.pm = fm + ((wgid % nig) % gsz); u.pn = (wgid % nig) / gsz; return true;
    }
    __device__ __forceinline__ void a_ready(const Unit&) const {}
    __device__ __forceinline__ void done(const Unit&) const {}
};

__device__ __forceinline__ unsigned cvt_pk_bf16(float lo, float hi) { unsigned r; asm volatile("v_cvt_pk_bf16_f32 %0, %1, %2" : "=v"(r) : "v"(lo), "v"(hi)); return r; }
typedef float f32x2 __attribute__((ext_vector_type(2)));
struct EpiBf16 {
    static constexpr bool PERM = true, AFTER_DRAIN = false;
    bf16_t* O; int ldc;
    __device__ __forceinline__ void operator()(const f32x4 (&acc)[2][2][4][2], const Unit& u, int wr, int wc, int fr, int fq) const {
        const int row0 = u.pm * BM + wr * 64 + fr; const int col0 = u.pn * BM + wc * 32 + 8 * fq;
#pragma unroll
        for (int ai = 0; ai < 2; ++ai)
#pragma unroll
            for (int m = 0; m < 4; ++m) { bf16_t* rowp = O + (size_t)(row0 + ai * HALF + m * 16) * ldc + col0;
#pragma unroll
                for (int bj = 0; bj < 2; ++bj) { const f32x4 v0 = acc[ai][bj][m][0], v1 = acc[ai][bj][m][1];
                    u32x4 w; w.x = cvt_pk_bf16(v0[0], v0[1]); w.y = cvt_pk_bf16(v0[2], v0[3]); w.z = cvt_pk_bf16(v1[0], v1[1]); w.w = cvt_pk_bf16(v1[2], v1[3]);
                    *(u32x4*)(rowp + bj * HALF) = w; } }
    }
};
__device__ __forceinline__ float silu_mul(float g, float u) { const float e = __expf(-g); return g * u * __builtin_amdgcn_rcpf(1.0f + e); }
struct EpiSwiglu {
    static constexpr bool PERM = true, AFTER_DRAIN = false;
    bf16_t* O; int ldc;
    __device__ __forceinline__ void operator()(const f32x4 (&acc)[2][2][4][2], const Unit& u, int wr, int wc, int fr, int fq) const {
        const int row0 = u.pm * BM + wr * 64 + fr; const int col0 = u.pn * HALF + wc * 32 + 8 * fq;
#pragma unroll
        for (int ai = 0; ai < 2; ++ai)
#pragma unroll
            for (int m = 0; m < 4; ++m) { bf16_t* rowp = O + (size_t)(row0 + ai * HALF + m * 16) * ldc + col0;
                const f32x4 g0 = acc[ai][0][m][0], g1 = acc[ai][0][m][1], u0 = acc[ai][1][m][0], u1 = acc[ai][1][m][1];
                u32x4 w;
                w.x = cvt_pk_bf16(silu_mul(g0[0], u0[0]), silu_mul(g0[1], u0[1])); w.y = cvt_pk_bf16(silu_mul(g0[2], u0[2]), silu_mul(g0[3], u0[3]));
                w.z = cvt_pk_bf16(silu_mul(g1[0], u1[0]), silu_mul(g1[1], u1[1])); w.w = cvt_pk_bf16(silu_mul(g1[2], u1[2]), silu_mul(g1[3], u1[3]));
                *(u32x4*)rowp = w; }
    }
};
template <class Epi, class Sched, bool ALIGN_EPI = false, bool SP2 = false>
__device__ __forceinline__ void gemm_phase(PG8_LAS unsigned char* lds, const Gemm g, const Sched& S, const Epi& E) {
    const int tid = threadIdx.x, wid = __builtin_amdgcn_readfirstlane(tid >> 6), lane = tid & 63, wr = wid >> 2, wc = wid & 3, fr = lane & 15, fq = lane >> 4;
    const int K = g.K, nt = K / BK;
    unsigned voffA[2], voffB[2];
#pragma unroll
    for (int i = 0; i < 2; ++i) { int R, C; stage_rc(tid * 16 + i * 8192, R, C); const int Rb = Epi::PERM ? ((R & ~31) + perm32(R & 31)) : R;
        voffA[i] = (unsigned)(R * K + C) * 2u; voffB[i] = (unsigned)(Rb * K + C) * 2u; }
    const size_t kstep = (size_t)(BK * 2);
    const size_t hstep = (size_t)HALF * K * 2;
    const size_t tstep = 2 * hstep;
    const unsigned ldsw = (unsigned)wid * 1024u;
    const int aoff = lds_byte(wr * 64 + fr, fq * 8), boff = lds_byte(wc * 32 + fr, fq * 8);
#define PG8_SA(b, h) (((b) * 2 + (h)) * HTB)
#define PG8_SB(b, h) ((4 + (b) * 2 + (h)) * HTB)
#define PG8_STAGE(bufoff, gbase, voff) do { _Pragma("unroll") for (int _i = 0; _i < 2; ++_i) \
        __builtin_amdgcn_global_load_lds((const unsigned*)((const char*)(gbase) + (voff)[_i]), (PG8_LAS unsigned*)(lds + (bufoff) + ldsw + _i * 8192), 16, 0, 0); } while (0)
#define PG8_LDA(dst, b, h) do { _Pragma("unroll") for (int m = 0; m < 4; ++m) _Pragma("unroll") for (int k = 0; k < 2; ++k) dst[m][k] = *(const PG8_LAS bf16x8*)(lds + PG8_SA(b, h) + aoff + m * 2048 + k * 1024); } while (0)
#define PG8_LDB(dst, b, h) do { _Pragma("unroll") for (int n = 0; n < 2; ++n) _Pragma("unroll") for (int k = 0; k < 2; ++k) dst[n][k] = *(const PG8_LAS bf16x8*)(lds + PG8_SB(b, h) + boff + n * 2048 + k * 1024); } while (0)
#define PG8_MMA(ai, bj, At, Bt) do { __builtin_amdgcn_s_setprio(1); _Pragma("unroll") for (int m = 0; m < 4; ++m) _Pragma("unroll") for (int n = 0; n < 2; ++n) _Pragma("unroll") for (int k = 0; k < 2; ++k) \
        acc[ai][bj][m][n] = __builtin_amdgcn_mfma_f32_16x16x32_bf16(Bt[n][k], At[m][k], acc[ai][bj][m][n], 0, 0, 0); __builtin_amdgcn_s_setprio(0); } while (0)
#define PG8_WAIT_V(n) asm volatile("s_waitcnt vmcnt(" #n ")" ::: "memory")
#define PG8_WAIT_L(n) asm volatile("s_waitcnt lgkmcnt(" #n ")" ::: "memory")
#define PG8_BAR __builtin_amdgcn_s_barrier()
#define PG8_SCHED __builtin_amdgcn_sched_barrier(0)
    Unit cur, nxt; int ui = 0;
    if (!S.next(0, cur)) return;
    f32x4 acc[2][2][4][2];
#pragma unroll
    for (int a = 0; a < 2; ++a)
#pragma unroll
        for (int b = 0; b < 2; ++b)
#pragma unroll
            for (int m = 0; m < 4; ++m)
#pragma unroll
                for (int n = 0; n < 2; ++n) acc[a][b][m][n] = (f32x4){0.f, 0.f, 0.f, 0.f};
    bf16x8 At[4][2], B0[2][2], B1[2][2];
    const char* cA = (const char*)g.A + (size_t)cur.pm * tstep; const char* cB = (const char*)g.Bt + (size_t)cur.pn * tstep;
    S.a_ready(cur);
    if constexpr (SP2) {
        PG8_STAGE(PG8_SB(0, 0), cB, voffB); PG8_STAGE(PG8_SB(0, 1), cB + hstep, voffB); PG8_STAGE(PG8_SA(0, 0), cA, voffA); PG8_STAGE(PG8_SA(0, 1), cA + hstep, voffA);
        if (wr == 1) PG8_BAR;
        PG8_WAIT_V(2); PG8_BAR;
        PG8_STAGE(PG8_SB(1, 0), cB + kstep, voffB); PG8_STAGE(PG8_SA(1, 0), cA + kstep, voffA); PG8_STAGE(PG8_SB(1, 1), cB + hstep + kstep, voffB);
        PG8_WAIT_V(6); PG8_BAR;
    } else {
        PG8_STAGE(PG8_SB(0, 0), cB, voffB); PG8_STAGE(PG8_SA(0, 0), cA, voffA); PG8_STAGE(PG8_SB(0, 1), cB + hstep, voffB); PG8_STAGE(PG8_SA(0, 1), cA + hstep, voffA);
        if (wr == 1) PG8_BAR;
        PG8_WAIT_V(4); PG8_BAR;
        PG8_STAGE(PG8_SB(1, 0), cB + kstep, voffB); PG8_STAGE(PG8_SA(1, 0), cA + kstep, voffA); PG8_STAGE(PG8_SB(1, 1), cB + hstep + kstep, voffB);
        PG8_WAIT_V(6); PG8_BAR;
    }
    for (;;) {
        const bool has_next = S.next(ui + 1, nxt);
        const char* nA = has_next ? (const char*)g.A + (size_t)nxt.pm * tstep : cA; const char* nB = has_next ? (const char*)g.Bt + (size_t)nxt.pn * tstep : cB;
        for (int t = 0; t < nt; t += 2) {
            const bool last = (t == nt - 2);
            const char* a1 = cA + (size_t)(t + 1) * kstep;
            const char* a2 = last ? nA : cA + (size_t)(t + 2) * kstep; const char* b2 = last ? nB : cB + (size_t)(t + 2) * kstep;
            const char* a3 = a2 + kstep; const char* b3 = b2 + kstep;
            if (last && has_next) S.a_ready(nxt);
            if constexpr (SP2) {
            PG8_LDB(B0, 0, 0); PG8_LDB(B1, 0, 1); PG8_SCHED; PG8_LDA(At, 0, 0); PG8_STAGE(PG8_SA(1, 1), a1 + hstep, voffA);
            PG8_WAIT_V(8); PG8_WAIT_L(0); PG8_BAR; PG8_MMA(0, 0, At, B0); PG8_MMA(0, 1, At, B1); PG8_BAR; PG8_SCHED;
            PG8_LDA(At, 0, 1); PG8_STAGE(PG8_SB(0, 0), b2, voffB); PG8_STAGE(PG8_SB(0, 1), b2 + hstep, voffB); PG8_STAGE(PG8_SA(0, 0), a2, voffA);
            PG8_WAIT_V(8); PG8_WAIT_L(0); PG8_BAR; PG8_MMA(1, 0, At, B0); PG8_MMA(1, 1, At, B1); PG8_BAR; PG8_SCHED;
            PG8_LDB(B0, 1, 0); PG8_LDB(B1, 1, 1); PG8_SCHED; PG8_LDA(At, 1, 0); PG8_STAGE(PG8_SA(0, 1), a2 + hstep, voffA);
            PG8_WAIT_V(8); PG8_WAIT_L(0); PG8_BAR; PG8_MMA(0, 0, At, B0); PG8_MMA(0, 1, At, B1); PG8_BAR; PG8_SCHED;
            PG8_LDA(At, 1, 1); PG8_STAGE(PG8_SB(1, 0), b3, voffB); PG8_STAGE(PG8_SB(1, 1), b3 + hstep, voffB); PG8_STAGE(PG8_SA(1, 0), a3, voffA);
            PG8_WAIT_V(8); PG8_WAIT_L(0); PG8_BAR; PG8_MMA(1, 0, At, B0); PG8_MMA(1, 1, At, B1); PG8_BAR; PG8_SCHED;
            } else {
            PG8_LDB(B0, 0, 0); PG8_SCHED; PG8_LDA(At, 0, 0); PG8_STAGE(PG8_SA(1, 1), a1 + hstep, voffA);
            PG8_WAIT_L(8); PG8_BAR; PG8_WAIT_L(0); PG8_MMA(0, 0, At, B0); PG8_BAR; PG8_SCHED;
            PG8_LDB(B1, 0, 1); PG8_STAGE(PG8_SB(0, 0), b2, voffB);
            PG8_BAR; PG8_WAIT_L(0); PG8_MMA(0, 1, At, B1); PG8_BAR;
            PG8_LDA(At, 0, 1); PG8_STAGE(PG8_SA(0, 0), a2, voffA);
            PG8_BAR; PG8_WAIT_L(0); PG8_MMA(1, 0, At, B0); PG8_BAR; PG8_SCHED;
            PG8_STAGE(PG8_SB(0, 1), b2 + hstep, voffB);
            PG8_WAIT_V(6); PG8_BAR; PG8_MMA(1, 1, At, B1); PG8_BAR;
            PG8_LDB(B0, 1, 0); PG8_SCHED; PG8_LDA(At, 1, 0); PG8_STAGE(PG8_SA(0, 1), a2 + hstep, voffA);
            PG8_WAIT_L(8); PG8_BAR; PG8_WAIT_L(0); PG8_MMA(0, 0, At, B0); PG8_BAR; PG8_SCHED;
            PG8_LDB(B1, 1, 1); PG8_STAGE(PG8_SB(1, 0), b3, voffB);
            PG8_BAR; PG8_WAIT_L(0); PG8_MMA(0, 1, At, B1); PG8_BAR;
            PG8_LDA(At, 1, 1); PG8_STAGE(PG8_SA(1, 0), a3, voffA);
            PG8_BAR; PG8_WAIT_L(0); PG8_MMA(1, 0, At, B0); PG8_BAR; PG8_SCHED;
            PG8_STAGE(PG8_SB(1, 1), b3 + hstep, voffB);
            PG8_WAIT_V(6); PG8_BAR; PG8_MMA(1, 1, At, B1); PG8_BAR;
            }
        }
        if constexpr (ALIGN_EPI) { if (wr == 0) PG8_BAR; }
        if constexpr (!Epi::AFTER_DRAIN) { E(acc, cur, wr, wc, fr, fq); S.done(cur); }
        if (!has_next) break;
#pragma unroll
        for (int a = 0; a < 2; ++a)
#pragma unroll
            for (int b = 0; b < 2; ++b)
#pragma unroll
                for (int m = 0; m < 4; ++m)
#pragma unroll
                    for (int n = 0; n < 2; ++n) acc[a][b][m][n] = (f32x4){0.f, 0.f, 0.f, 0.f};
        cur = nxt; cA = nA; cB = nB; ++ui;
        if constexpr (ALIGN_EPI) { if (wr == 1) PG8_BAR; }
    }
    PG8_WAIT_V(0);
    if constexpr (!ALIGN_EPI) { if (wr == 0) PG8_BAR; }
    PG8_BAR;
    if constexpr (Epi::AFTER_DRAIN) { E.fused(acc, cur, wr, wc, fr, fq, lds, wid, lane); S.done(cur); }
#undef PG8_SA
#undef PG8_SB
#undef PG8_STAGE
#undef PG8_LDA
#undef PG8_LDB
#undef PG8_MMA
#undef PG8_WAIT_V
#undef PG8_WAIT_L
#undef PG8_BAR
#undef PG8_SCHED
}
}

constexpr int NWAVES = 8, NTHR = NWAVES * 64;
constexpr int BATCH = 4, SEQ = 4096, D = 1024, FF = 2816, M = BATCH * SEQ;
constexpr int NZ = 3072, WINC = 3088;
constexpr int NH = 4, DK = 64, DV = 128, CH = 128, NC = SEQ / CH;
constexpr int Z_BG = 0, Z_CG = 512, Z_HC = 1024, Z_Q = 1536, Z_K = 1792, Z_V = 2048, Z_O = 2560;
constexpr float EPS = 1e-6f, NEG_INF = -1e30f;
constexpr int N_PHASES = 13;
#ifndef REP_5
#define REP_5 1
#endif
#ifndef REP_7
#define REP_7 1
#endif
#ifndef REP_0
#define REP_0 1
#endif
#ifndef REP_1
#define REP_1 1
#endif
#ifndef REP_3
#define REP_3 1
#endif
#ifndef REP_M
#define REP_M 1
#endif
#ifndef SYNC_REP
#define SYNC_REP 1
#endif
#ifndef MK_CUTS
#define MK_CUTS {0, N_PHASES}
#endif

constexpr size_t MiB = 1u << 20;
constexpr size_t WS_W1I = 1 * MiB, WS_W1O = 12 * MiB, WS_WMI = 35 * MiB / 2, WS_WMO = 47 * MiB / 2, WS_W2I = 51 * MiB / 2, WS_W2O = 73 * MiB / 2, WS_WG = 42 * MiB;
constexpr size_t WS_XN = 44 * MiB;
constexpr size_t WS_ACT = 76 * MiB;
constexpr size_t WS_H = 172 * MiB;
constexpr size_t WS_G = 204 * MiB;
constexpr size_t WS_CC = 205 * MiB;
constexpr size_t WS_CP = 237 * MiB;
constexpr size_t WS_SM = 253 * MiB;
constexpr size_t WS_END = 254 * MiB;
constexpr int LDS_BYTES = 147456;

#define GAS __attribute__((address_space(1)))
#define LAS __attribute__((address_space(3)))
typedef unsigned short bf16;
typedef unsigned v4u __attribute__((ext_vector_type(4)));
typedef unsigned v2u __attribute__((ext_vector_type(2)));
typedef float f32x4 __attribute__((ext_vector_type(4)));
typedef short bf16x8 __attribute__((ext_vector_type(8)));
#define LDS_WAIT() asm volatile("s_waitcnt lgkmcnt(0)" ::: "memory")
__device__ __forceinline__ unsigned f2bf(float f) { unsigned u = __builtin_bit_cast(unsigned, f); return (u + 0x7fffu + ((u >> 16) & 1u)) >> 16; }
__device__ __forceinline__ unsigned pk2(float lo, float hi) { return f2bf(lo) | (f2bf(hi) << 16); }
__device__ __forceinline__ float bflo(unsigned w) { return __uint_as_float(w << 16); }
__device__ __forceinline__ float bfhi(unsigned w) { return __uint_as_float(w & 0xffff0000u); }
__device__ __forceinline__ float bf2f(bf16 h) { return __uint_as_float((unsigned)h << 16); }
typedef float f32x16 __attribute__((ext_vector_type(16)));
typedef float f32x2_t __attribute__((ext_vector_type(2))); typedef __bf16 bf16x2_t __attribute__((ext_vector_type(2)));
__device__ __forceinline__ unsigned cvtpk(float lo, float hi) { f32x2_t v = {lo, hi}; bf16x2_t b = __builtin_convertvector(v, bf16x2_t); return __builtin_bit_cast(unsigned, b); }
#define MFMA32(a, b, c) __builtin_amdgcn_mfma_f32_32x32x16_bf16((a), (b), (c), 0, 0, 0)
__device__ __forceinline__ float wave_sum(float v) {
#pragma unroll
    for (int o = 1; o < 64; o <<= 1) v += __shfl_xor(v, o);
    return v;
}


__device__ __forceinline__ float lane_scan_sum(float s, int lane) {
#pragma unroll
    for (int o = 1; o < 64; o <<= 1) { const float v = __shfl_up(s, o); if (lane >= o) s += v; }
    return s;
}
__device__ __forceinline__ float lane_scan_max(float s, int lane) {
#pragma unroll
    for (int o = 1; o < 64; o <<= 1) { const float v = __shfl_up(s, o); if (lane >= o) s = fmaxf(s, v); }
    return s;
}
__device__ __forceinline__ float wave_max(float v) {
#pragma unroll
    for (int o = 1; o < 64; o <<= 1) v = fmaxf(v, __shfl_xor(v, o));
    return v;
}

__device__ __forceinline__ void transpose_item(const float* __restrict__ W, int ldw, int k0, int c0, bf16* __restrict__ WT, int K, int r0, LAS float* scr, int lane) {
#pragma unroll 8
    for (int i = 0; i < 32; ++i) { const int kk = 2 * i + (lane >> 5); scr[kk * 33 + (lane & 31)] = W[(size_t)(k0 + kk) * ldw + c0 + (lane & 31)]; }
    LDS_WAIT(); asm volatile("" ::: "memory");
    const int c = lane & 7;
#pragma unroll
    for (int j = 0; j < 4; ++j) { const int n = (lane >> 3) + 8 * j; const LAS float* s = scr + (8 * c) * 33 + n;
        v4u o; o.x = pk2(s[0 * 33], s[1 * 33]); o.y = pk2(s[2 * 33], s[3 * 33]); o.z = pk2(s[4 * 33], s[5 * 33]); o.w = pk2(s[6 * 33], s[7 * 33]);
        *(v4u*)(WT + (size_t)(r0 + n) * K + k0 + 8 * c) = o; }
    LDS_WAIT(); asm volatile("" ::: "memory");
}
__device__ __forceinline__ int swiglu_row(int c0) { const int s = c0 / FF, j = c0 % FF; return 256 * (j / 128) + 128 * s + (j % 128); }

template <bool HAS_H, bool HAS_NEXT>
__device__ __forceinline__ void norm_rows(const float* xin, const bf16* H, const float* gpost, float scale, float* xout, const float* gpre, bf16* XN, int gw, int NGW, int lane) {
    f32x4 gp[4], gn[4];
#pragma unroll
    for (int j = 0; j < 4; ++j) { if (HAS_H) gp[j] = ((const f32x4*)gpost)[lane + 64 * j]; if (HAS_NEXT) gn[j] = ((const f32x4*)gpre)[lane + 64 * j]; }
    for (int m = gw; m < M; m += NGW) {
        f32x4 v[4];
#pragma unroll
        for (int j = 0; j < 4; ++j) v[j] = ((const f32x4*)(xin + (size_t)m * D))[lane + 64 * j];
        if (HAS_H) {
            f32x4 hv[4]; float s = 0.f;
#pragma unroll
            for (int j = 0; j < 4; ++j) { const v2u w = ((const v2u*)(H + (size_t)m * D))[lane + 64 * j]; hv[j] = (f32x4){bflo(w.x), bfhi(w.x), bflo(w.y), bfhi(w.y)};
                s += (hv[j].x * hv[j].x + hv[j].y * hv[j].y) + (hv[j].z * hv[j].z + hv[j].w * hv[j].w); }
            const float rh = scale / sqrtf(wave_sum(s) * (1.f / D) + EPS);
#pragma unroll
            for (int j = 0; j < 4; ++j) { v[j] = v[j] + hv[j] * gp[j] * rh; ((f32x4*)(xout + (size_t)m * D))[lane + 64 * j] = v[j]; }
        }
        if (HAS_NEXT) {
            float s = 0.f;
#pragma unroll
            for (int j = 0; j < 4; ++j) s += (v[j].x * v[j].x + v[j].y * v[j].y) + (v[j].z * v[j].z + v[j].w * v[j].w);
            const float r = 1.0f / sqrtf(wave_sum(s) * (1.f / D) + EPS);
#pragma unroll
            for (int j = 0; j < 4; ++j) { const f32x4 o = v[j] * gn[j] * r; v2u w; w.x = pk2(o.x, o.y); w.y = pk2(o.z, o.w); ((v2u*)(XN + (size_t)m * D))[lane + 64 * j] = w; }
        }
    }
}

__device__ __forceinline__ void ld8(const bf16* p, float (&o)[8]) { const v4u w = *(const v4u*)p; o[0] = bflo(w.x); o[1] = bfhi(w.x); o[2] = bflo(w.y); o[3] = bfhi(w.y); o[4] = bflo(w.z); o[5] = bfhi(w.z); o[6] = bflo(w.w); o[7] = bfhi(w.w); }

#define XB_TMO      128
#define XB_XCNT(j)  (256  + 64 * (j))
#define XB_XSUB(j)  (1280 + 64 * (j))
#define XB_XGEN(j)  (2304 + 64 * (j))
#define XB_TOP      3328
#define XB_TOPGEN   3392
#define XCD_BAR_WORDS 3456
#define XB_SPIN_CAP (1u << 18)

__device__ __forceinline__ unsigned xb_ld(unsigned* p)              { return __hip_atomic_load(p, __ATOMIC_RELAXED, __HIP_MEMORY_SCOPE_AGENT); }
__device__ __forceinline__ unsigned xb_add(unsigned* p, unsigned v) { return __hip_atomic_fetch_add(p, v, __ATOMIC_RELAXED, __HIP_MEMORY_SCOPE_AGENT); }
__device__ __forceinline__ unsigned xb_xcc_id() { return (unsigned)__builtin_amdgcn_s_getreg((3 << 11) | 20) & 0xFu; }
#define XB_SPIN(cond, bar) do { unsigned _sp = 0; while (cond) { __builtin_amdgcn_s_sleep(1); \
    if ((++_sp & 255u) == 0u) { if (xb_ld(&(bar)[XB_TMO])) break; if (_sp > XB_SPIN_CAP) { atomicAdd(&(bar)[XB_TMO], 1u); break; } } } } while (0)

struct XcdBarrier {
    unsigned* bar; unsigned x;
    volatile LAS unsigned* st;
};

__device__ __forceinline__ XcdBarrier xcd_barrier_post(unsigned* bar, volatile LAS unsigned* st) {
    XcdBarrier b; b.bar = bar; b.x = xb_xcc_id(); b.st = st;
    if (threadIdx.x == 0) (void)xb_add(&bar[XB_XCNT(b.x)], 1u);
    return b;
}
__device__ __forceinline__ void xcd_barrier_complete(unsigned* bar, unsigned x, unsigned& nloc, unsigned& nx) {
    const unsigned G = gridDim.x * gridDim.y * gridDim.z;
    unsigned sum, cnt, mine, sp = 0u;
    for (;;) {
        sum = 0u; cnt = 0u; mine = 0u;
#pragma unroll
        for (unsigned j = 0; j < 16; ++j) { const unsigned c = xb_ld(&bar[XB_XCNT(j)]); sum += c; cnt += (c > 0u) ? 1u : 0u; mine = (j == x) ? c : mine; }
        if (sum == G) break;
        __builtin_amdgcn_s_sleep(1);
        if ((++sp & 255u) == 0u) { if (xb_ld(&bar[XB_TMO])) break; if (sp > XB_SPIN_CAP) { atomicAdd(&bar[XB_TMO], 1u); break; } }
    }
    nloc = mine > 0u ? mine : 1u; nx = cnt > 0u ? cnt : 1u;
}

__device__ __forceinline__ void xcd_barrier(const XcdBarrier& b) {
    asm volatile("s_waitcnt vmcnt(0)" ::: "memory");
    __syncthreads();
    if (threadIdx.x == 0) {
        unsigned* bar = b.bar;
        __builtin_amdgcn_s_waitcnt(0);
        unsigned nloc = b.st[0], nx = b.st[1];
        if (nloc == 0u) { xcd_barrier_complete(bar, b.x, nloc, nx); b.st[0] = nloc; b.st[1] = nx; }
        const unsigned old = xb_add(&bar[XB_XSUB(b.x)], 1u);
        const unsigned gen = old / nloc;
        if (old + 1u == (gen + 1u) * nloc) {
            __builtin_amdgcn_fence(__ATOMIC_RELEASE, "agent");
            asm volatile("s_waitcnt vmcnt(0)" ::: "memory");
            const unsigned og = xb_add(&bar[XB_TOP], 1u);
            const unsigned tg = og / nx;
            if (og + 1u == (tg + 1u) * nx) xb_add(&bar[XB_TOPGEN], 1u);
            else XB_SPIN(xb_ld(&bar[XB_TOPGEN]) == tg, bar);
            __builtin_amdgcn_fence(__ATOMIC_ACQUIRE, "agent");
            xb_add(&bar[XB_XGEN(b.x)], 1u);
            asm volatile("s_waitcnt vmcnt(0)" ::: "memory");
        } else {
            XB_SPIN(xb_ld(&bar[XB_XGEN(b.x)]) == gen, bar);
            __builtin_amdgcn_fence(__ATOMIC_ACQUIRE, "agent");
            asm volatile("s_waitcnt vmcnt(0)" ::: "memory");
        }
    }
    __syncthreads();
}

struct Args { const float* in[18]; float* out; unsigned char* ws; int ph_lo, ph_hi; };
__global__ void __launch_bounds__(NTHR, 2) fwd(Args args) {
    extern __shared__ __attribute__((aligned(16))) unsigned char lds_raw[];
    LAS unsigned char* lds = (LAS unsigned char*)lds_raw;
    cg::grid_group grid = cg::this_grid();
    const int tid = threadIdx.x, lane = tid & 63, wave = __builtin_amdgcn_readfirstlane(tid >> 6);
    const int G = gridDim.x, gw = blockIdx.x * NWAVES + wave, NGW = G * NWAVES;
    unsigned char* ws = args.ws;
    const float* x = args.in[0]; float* out = args.out;
    bf16* W1I = (bf16*)(ws + WS_W1I); bf16* W1O = (bf16*)(ws + WS_W1O); bf16* WMI = (bf16*)(ws + WS_WMI); bf16* WMO = (bf16*)(ws + WS_WMO);
    bf16* W2I = (bf16*)(ws + WS_W2I); bf16* W2O = (bf16*)(ws + WS_W2O); bf16* WGT = (bf16*)(ws + WS_WG);
    bf16* XN = (bf16*)(ws + WS_XN); bf16* Y = XN; bf16* ACT = (bf16*)(ws + WS_ACT); bf16* Z = ACT; bf16* H = (bf16*)(ws + WS_H);
    float* Gt = (float*)(ws + WS_G); float* CC = (float*)(ws + WS_CC); bf16* CP = (bf16*)(ws + WS_CP);
    float* NCc = (float*)(ws + WS_SM); float* NPp = NCc + 1024 * 64; float* GC = NPp + 1024 * 64; float* MC = GC + 1024; float* MP = MC + 1024;
    const int lo = args.ph_lo, hi = args.ph_hi;
    volatile LAS unsigned* bst = (volatile LAS unsigned*)(lds + LDS_BYTES - 64);
    if (tid < 16) bst[tid] = 0u;
    __syncthreads();
    const XcdBarrier bar = xcd_barrier_post((unsigned*)ws, bst);
#define IN(k) (lo <= (k) && (k) < hi)
#ifndef USE_CG_FIRST
#define USE_CG_FIRST 1
#endif
#define SEAM(k) do { if (IN(k) && IN((k) + 1)) { for (int sr_ = 0; sr_ < SYNC_REP; ++sr_) { if (USE_CG_FIRST && (k) == 0) grid.sync(); else xcd_barrier(bar); } } } while (0)

    if (IN(0)) {
        LAS float* scr = (LAS float*)(lds + wave * 16384);
        constexpr int I_FI = 16 * 176, I_FO = 44 * 32, I_MI = 16 * 96, I_MO = 16 * 32, NITEMS = 2 * (I_FI + I_FO) + I_MI + I_MO;
        for (int it = gw; it < NITEMS; it += NGW) {
            int r = it;
            if (r < I_FI) { const int kb = r / 176, nb = r % 176; transpose_item(args.in[3], 2 * FF, 64 * kb, 32 * nb, W1I, D, swiglu_row(32 * nb), scr, lane); continue; } r -= I_FI;
            if (r < I_FI) { const int kb = r / 176, nb = r % 176; transpose_item(args.in[16], 2 * FF, 64 * kb, 32 * nb, W2I, D, swiglu_row(32 * nb), scr, lane); continue; } r -= I_FI;
            if (r < I_FO) { const int kb = r / 32, nb = r % 32; transpose_item(args.in[4], D, 64 * kb, 32 * nb, W1O, FF, 32 * nb, scr, lane); continue; } r -= I_FO;
            if (r < I_FO) { const int kb = r / 32, nb = r % 32; transpose_item(args.in[17], D, 64 * kb, 32 * nb, W2O, FF, 32 * nb, scr, lane); continue; } r -= I_FO;
            if (r < I_MI) { const int kb = r / 96, nb = r % 96; transpose_item(args.in[7], WINC, 64 * kb, 32 * nb, WMI, D, 32 * nb, scr, lane); continue; } r -= I_MI;
            { const int kb = r / 32, nb = r % 32; transpose_item(args.in[13], D, 64 * kb, 32 * nb, WMO, D, 32 * nb, scr, lane); }
        }
        for (int e = blockIdx.x * NTHR + tid; e < 16 * D; e += G * NTHR) { const int g = e / D, k = e % D; WGT[e] = (bf16)f2bf(args.in[7][(size_t)k * WINC + NZ + g]); }
        norm_rows<false, true>(x, nullptr, nullptr, 0.f, nullptr, args.in[1], XN, gw, NGW, lane);
    }
    SEAM(0);
    if (IN(1)) {
        pg8::Gemm g{XN, W1I, M, 2 * FF, D}; pg8::StaticOrder S; S.init(M, 2 * FF, G, (int)blockIdx.x);
        pg8::EpiSwiglu E{ACT, FF};
        pg8::gemm_phase<pg8::EpiSwiglu, pg8::StaticOrder, true, true>(lds, g, S, E);
    }
    SEAM(1);
    if (IN(2)) {
        pg8::Gemm g{ACT, W1O, M, D, FF}; pg8::StaticOrder S; S.init(M, D, G, (int)blockIdx.x);
        pg8::EpiBf16 E{H, D};
        pg8::gemm_phase<pg8::EpiBf16, pg8::StaticOrder, true, true>(lds, g, S, E);
    }
    SEAM(2);
    if (IN(3)) norm_rows<true, true>(x, H, args.in[2], 0.5f, out, args.in[5], XN, gw, NGW, lane);
    SEAM(3);
    if (IN(4)) {
        const int fr = lane & 15, fq = lane >> 4;
        for (int rb = gw; rb < M / 16; rb += NGW) {
            f32x4 acc = {0.f, 0.f, 0.f, 0.f};
            const bf16* arow = XN + (size_t)(rb * 16 + fr) * D + fq * 8; const bf16* brow = WGT + (size_t)fr * D + fq * 8;
#pragma unroll 8
            for (int kk = 0; kk < D / 32; ++kk) { const bf16x8 a = *(const bf16x8*)(arow + kk * 32); const bf16x8 b = *(const bf16x8*)(brow + kk * 32);
                acc = __builtin_amdgcn_mfma_f32_16x16x32_bf16(b, a, acc, 0, 0, 0); }
            f32x4 o;
#pragma unroll
            for (int i = 0; i < 4; ++i) { const int gcol = 4 * fq + i;
                if (gcol < 8) o[i] = acc[i] + args.in[10][gcol];
                else { const float v = acc[i] + args.in[11][gcol - 8]; o[i] = fminf(v, 0.f) - log1pf(__expf(-fabsf(v))); } }
            *(f32x4*)(Gt + (size_t)(rb * 16 + fr) * 16 + 4 * fq) = o;
        }
        pg8::Gemm g{XN, WMI, M, NZ, D}; pg8::StaticOrder S; S.init(M, NZ, G, (int)blockIdx.x);
        pg8::EpiBf16 E{Z, NZ};
        pg8::gemm_phase<pg8::EpiBf16, pg8::StaticOrder, true, true>(lds, g, S, E);
    }
    SEAM(4);
    for (int rep_m = 0; rep_m < REP_M; ++rep_m) {
    for (int rep5 = 0; rep5 < REP_5; ++rep5)
    if (IN(5)) {
        {
        constexpr int VP = 132;
        LAS bf16* VTs = (LAS bf16*)lds; LAS bf16* KeT = VTs + DV * VP;
        LAS float* ev = (LAS float*)(KeT + 2 * DK * VP);
        const int l31 = lane & 31, hh = lane >> 5, d = wave >> 2, dvb = wave & 3;
        for (int it2 = blockIdx.x; it2 < BATCH * NH * NC; it2 += G) {
            const int b = it2 >> 7, h = (it2 >> 5) & 3, c = it2 & 31, r0 = b * SEQ + c * CH;
            __syncthreads();
#pragma unroll
            for (int j = 0; j < 4; ++j) { const int e = tid + NTHR * j, sr = e & 127, c16 = e >> 7;
                const v4u w = *(const v4u*)(Z + (size_t)(r0 + sr) * NZ + Z_V + h * DV + c16 * 8); LAS bf16* vp = VTs + (c16 * 8) * VP + sr;
                vp[0 * VP] = (bf16)(w.x & 0xffffu); vp[1 * VP] = (bf16)(w.x >> 16); vp[2 * VP] = (bf16)(w.y & 0xffffu); vp[3 * VP] = (bf16)(w.y >> 16);
                vp[4 * VP] = (bf16)(w.z & 0xffffu); vp[5 * VP] = (bf16)(w.z >> 16); vp[6 * VP] = (bf16)(w.w & 0xffffu); vp[7 * VP] = (bf16)(w.w >> 16); }
            if (wave < 2) {
                const int gd = wave, itg = ((gd * BATCH + b) * NH + h) * NC + c;
                const int t0 = gd ? 127 - 2 * lane : 2 * lane, t1 = gd ? 126 - 2 * lane : 2 * lane + 1;
                const float lf0 = Gt[(size_t)(r0 + t0) * 16 + 8 + gd * 4 + h], lf1 = Gt[(size_t)(r0 + t1) * 16 + 8 + gd * 4 + h];
                const float li0 = Gt[(size_t)(r0 + t0) * 16 + gd * 4 + h], li1 = Gt[(size_t)(r0 + t1) * 16 + gd * 4 + h];
                const float tot = lf0 + lf1, incl = lane_scan_sum(tot, lane), b0 = incl - tot + lf0, b1 = b0 + lf1;
                const float gsum = __shfl(incl, 63);
                const float w0 = gsum - b0 + li0, w1 = gsum - b1 + li1, mx = wave_max(fmaxf(w0, w1));
                ev[gd * CH + t0] = __expf(w0 - mx); ev[gd * CH + t1] = __expf(w1 - mx);
                if (lane == 0) { GC[itg] = gsum; MC[itg] = mx; }
            }
            __syncthreads();
#pragma unroll
            for (int j = 0; j < 2; ++j) { const int e = tid + NTHR * j, tr = e & 127, c8 = e >> 7; float f[8]; ld8(Z + (size_t)(r0 + tr) * NZ + Z_K + h * DK + c8 * 8, f);
                const float e0 = ev[tr], e1 = ev[CH + tr]; LAS bf16* kp = KeT + (c8 * 8) * VP + tr;
#pragma unroll
                for (int i = 0; i < 8; ++i) { kp[i * VP] = (bf16)f2bf(f[i] * e0); kp[(DK + i) * VP] = (bf16)f2bf(f[i] * e1); } }
            __syncthreads();
            const int it = ((d * BATCH + b) * NH + h) * NC + c;
            f32x16 acc[2];
#pragma unroll
            for (int nt = 0; nt < 2; ++nt)
#pragma unroll
                for (int i = 0; i < 16; ++i) acc[nt][i] = 0.f;
#pragma unroll
            for (int ks = 0; ks < 8; ++ks) { const LAS bf16* ap = VTs + (32 * dvb + l31) * VP + 16 * ks + 8 * hh;
                const v2u a0 = *(const LAS v2u*)ap, a1 = *(const LAS v2u*)(ap + 4); v4u aw; aw.x = a0.x; aw.y = a0.y; aw.z = a1.x; aw.w = a1.y;
#pragma unroll
                for (int nt = 0; nt < 2; ++nt) { const LAS bf16* bp = KeT + (d * DK + 32 * nt + l31) * VP + 16 * ks + 8 * hh;
                    const v2u b0 = *(const LAS v2u*)bp, b1 = *(const LAS v2u*)(bp + 4); v4u bw; bw.x = b0.x; bw.y = b0.y; bw.z = b1.x; bw.w = b1.y;
                    acc[nt] = MFMA32(__builtin_bit_cast(bf16x8, aw), __builtin_bit_cast(bf16x8, bw), acc[nt]); } }
#pragma unroll
            for (int nt = 0; nt < 2; ++nt)
#pragma unroll
                for (int i = 0; i < 16; ++i) CC[(size_t)it * (DV * DK) + (32 * dvb + (i & 3) + 8 * (i >> 2) + 4 * hh) * DK + 32 * nt + l31] = acc[nt][i];
            if (tid < 2 * DK) { const int nd = tid >> 6, ndk = tid & 63; const LAS bf16* kp = KeT + (nd * DK + ndk) * VP; float n = 0.f;
#pragma unroll
                for (int i = 0; i < 32; ++i) { const v2u w = *(const LAS v2u*)(kp + 4 * i); n += (bflo(w.x) + bfhi(w.x)) + (bflo(w.y) + bfhi(w.y)); }
                NCc[(((nd * BATCH + b) * NH + h) * NC + c) * DK + ndk] = n; }
        }
        }
        const float* cw = args.in[8]; const float* cb = args.in[9];
        for (int rb = blockIdx.x; rb < M / 64; rb += G) {
            const int c0 = (tid & 63) * 8, rsub = tid >> 6;
            float w0[8], w1[8], w2[8], bb[8];
#pragma unroll
            for (int i = 0; i < 8; ++i) { w0[i] = cw[c0 + i]; w1[i] = cw[512 + c0 + i]; w2[i] = cw[1024 + c0 + i]; bb[i] = cb[c0 + i]; }
            for (int p = 0; p < 8; ++p) {
                const int row = rb * 64 + p * 8 + rsub, t = row & (SEQ - 1);
                float a[8], bq[8], um[8], u0[8], up[8], bg[8];
                ld8(Z + (size_t)row * NZ + Z_CG + c0, a); ld8(Z + (size_t)row * NZ + Z_HC + c0, bq);
#pragma unroll
                for (int i = 0; i < 8; ++i) u0[i] = a[i] * bq[i];
                if (t > 0) { ld8(Z + (size_t)(row - 1) * NZ + Z_CG + c0, a); ld8(Z + (size_t)(row - 1) * NZ + Z_HC + c0, bq);
#pragma unroll
                    for (int i = 0; i < 8; ++i) um[i] = a[i] * bq[i]; }
                else {
#pragma unroll
                    for (int i = 0; i < 8; ++i) um[i] = 0.f; }
                if (t < SEQ - 1) { ld8(Z + (size_t)(row + 1) * NZ + Z_CG + c0, a); ld8(Z + (size_t)(row + 1) * NZ + Z_HC + c0, bq);
#pragma unroll
                    for (int i = 0; i < 8; ++i) up[i] = a[i] * bq[i]; }
                else {
#pragma unroll
                    for (int i = 0; i < 8; ++i) up[i] = 0.f; }
                ld8(Z + (size_t)row * NZ + Z_BG + c0, bg);
                float y[8];
#pragma unroll
                for (int i = 0; i < 8; ++i) y[i] = bg[i] * (w0[i] * um[i] + w1[i] * u0[i] + w2[i] * up[i] + bb[i]);
                v4u o; o.x = pk2(y[0], y[1]); o.y = pk2(y[2], y[3]); o.z = pk2(y[4], y[5]); o.w = pk2(y[6], y[7]);
                *(v4u*)(Y + (size_t)row * D + c0) = o;
            }
        }
    }
    SEAM(5);
    if (IN(6)) {
        LAS float* sa = (LAS float*)lds; LAS float* ss = sa + 128;
        for (int unit = blockIdx.x; unit < 256; unit += G) {
            const int seq = unit >> 3, part = unit & 7, dir = seq >> 4;
            const int e0 = part * 1024 + 2 * tid;
            const bool nthr = (part == 0 && tid < DK);
            __syncthreads();
            if (tid < NC) { const int it = seq * NC + (dir ? NC - 1 - tid : tid); sa[64 + tid] = GC[it]; ss[64 + tid] = MC[it]; }
            float2 cc[NC]; float ncv[NC];
#pragma unroll
            for (int ci = 0; ci < NC; ++ci) { const int it = seq * NC + (dir ? NC - 1 - ci : ci); cc[ci] = *(const float2*)(CC + (size_t)it * (DV * DK) + e0); ncv[ci] = nthr ? NCc[it * DK + tid] : 0.f; }
            __syncthreads();
            if (tid == 0) { float m = NEG_INF;
                for (int ci = 0; ci < NC; ++ci) { const int it = seq * NC + (dir ? NC - 1 - ci : ci);
                    if (part == 0) MP[it] = m;
                    const float gcv = sa[64 + ci], mcv = ss[64 + ci], mn = fmaxf(gcv + m, mcv);
                    sa[ci] = __expf(gcv + m - mn); ss[ci] = __expf(mcv - mn); m = mn; } }
            __syncthreads();
            float c0 = 0.f, c1 = 0.f, n = 0.f;
#pragma unroll
            for (int ci = 0; ci < NC; ++ci) { const int it = seq * NC + (dir ? NC - 1 - ci : ci);
                *(unsigned*)(CP + (size_t)it * (DV * DK) + e0) = pk2(c0, c1);
                const float a = sa[ci], sc = ss[ci];
                c0 = a * c0 + sc * cc[ci].x; c1 = a * c1 + sc * cc[ci].y;
                if (nthr) { NPp[it * DK + tid] = n; n = a * n + sc * ncv[ci]; } }
        }
    }
    SEAM(6);
    for (int rep7 = 0; rep7 < REP_7; ++rep7)
    if (IN(7)) {
        constexpr int QP = 72, VP = 132, HP = 132;
        LAS bf16* Qs = (LAS bf16*)lds; LAS bf16* Ks = Qs + CH * QP; LAS bf16* VTs = Ks + CH * QP;
        LAS float* gv = (LAS float*)(VTs + DV * VP);
        LAS float* HB = gv + 2 * 6 * CH;
        const float* hgain = args.in[12];
        const int l31 = lane & 31, hh = lane >> 5, d = wave >> 2, rb = wave & 3;
        for (int it2 = blockIdx.x; it2 < BATCH * NH * NC; it2 += G) {
            const int b = it2 >> 7, h = (it2 >> 5) & 3, c = it2 & 31, r0 = b * SEQ + c * CH;
            __syncthreads();
#pragma unroll
            for (int j = 0; j < 2; ++j) { const int e = tid + NTHR * j, row = e >> 3, c8 = e & 7;
                const v4u wq = *(const v4u*)(Z + (size_t)(r0 + row) * NZ + Z_Q + h * DK + c8 * 8); v4u o;
                o.x = pk2(bflo(wq.x) * 0.125f, bfhi(wq.x) * 0.125f); o.y = pk2(bflo(wq.y) * 0.125f, bfhi(wq.y) * 0.125f); o.z = pk2(bflo(wq.z) * 0.125f, bfhi(wq.z) * 0.125f); o.w = pk2(bflo(wq.w) * 0.125f, bfhi(wq.w) * 0.125f);
                *(LAS v4u*)(Qs + row * QP + c8 * 8) = o;
                *(LAS v4u*)(Ks + row * QP + c8 * 8) = *(const v4u*)(Z + (size_t)(r0 + row) * NZ + Z_K + h * DK + c8 * 8); }
#pragma unroll
            for (int j = 0; j < 4; ++j) { const int e = tid + NTHR * j, sr = e & 127, c16 = e >> 7;
                const v4u w = *(const v4u*)(Z + (size_t)(r0 + sr) * NZ + Z_V + h * DV + c16 * 8); LAS bf16* vp = VTs + (c16 * 8) * VP + sr;
                vp[0 * VP] = (bf16)(w.x & 0xffffu); vp[1 * VP] = (bf16)(w.x >> 16); vp[2 * VP] = (bf16)(w.y & 0xffffu); vp[3 * VP] = (bf16)(w.y >> 16);
                vp[4 * VP] = (bf16)(w.z & 0xffffu); vp[5 * VP] = (bf16)(w.z >> 16); vp[6 * VP] = (bf16)(w.w & 0xffffu); vp[7 * VP] = (bf16)(w.w >> 16); }
            if (wave < 2) {
                const int gd = wave, itg = ((gd * BATCH + b) * NH + h) * NC + c;
                const int t0 = gd ? 127 - 2 * lane : 2 * lane, t1 = gd ? 126 - 2 * lane : 2 * lane + 1;
                const float lf0 = Gt[(size_t)(r0 + t0) * 16 + 8 + gd * 4 + h], lf1 = Gt[(size_t)(r0 + t1) * 16 + 8 + gd * 4 + h];
                const float li0 = Gt[(size_t)(r0 + t0) * 16 + gd * 4 + h], li1 = Gt[(size_t)(r0 + t1) * 16 + gd * 4 + h];
                const float mprev = MP[itg];
                const float tot = lf0 + lf1, incl = lane_scan_sum(tot, lane), b0 = incl - tot + lf0, b1 = b0 + lf1;
                const float be0 = li0 - b0, be1 = li1 - b1, mloc = fmaxf(be0, be1), minc = lane_scan_max(mloc, lane);
                float mex = __shfl_up(minc, 1); if (lane == 0) mex = -3.0e38f;
                const float c0 = fmaxf(mex, be0), c1 = fmaxf(c0, be1);
                const float mt0 = fmaxf(b0 + mprev, b0 + c0), mt1 = fmaxf(b1 + mprev, b1 + c1);
                LAS float* g6 = gv + gd * 6 * CH;
                g6[1 * CH + t0] = be0; g6[1 * CH + t1] = be1;
                g6[2 * CH + t0] = b0 - mt0; g6[2 * CH + t1] = b1 - mt1;
                g6[3 * CH + t0] = __expf(b0 + mprev - mt0); g6[3 * CH + t1] = __expf(b1 + mprev - mt1);
                g6[4 * CH + t0] = __expf(-mt0); g6[4 * CH + t1] = __expf(-mt1);
            }
            __syncthreads();
            const int it = ((d * BATCH + b) * NH + h) * NC + c;
            const LAS float* gvd = gv + d * 6 * CH;
            bf16x8 qf[4];
#pragma unroll
            for (int kk = 0; kk < 4; ++kk) qf[kk] = *(const LAS bf16x8*)(Qs + (32 * rb + l31) * QP + 16 * kk + 8 * hh);
            f32x16 acc[4];
#pragma unroll
            for (int nt = 0; nt < 4; ++nt) {
#pragma unroll
                for (int i = 0; i < 16; ++i) acc[nt][i] = 0.f;
#pragma unroll
                for (int kk = 0; kk < 4; ++kk) { const bf16x8 cb = *(const bf16x8*)(CP + (size_t)it * (DV * DK) + (32 * nt + l31) * DK + 16 * kk + 8 * hh); acc[nt] = MFMA32(qf[kk], cb, acc[nt]); } }
#pragma unroll
            for (int g = 0; g < 4; ++g) { const f32x4 iv = *(const LAS f32x4*)(gvd + 3 * CH + 32 * rb + 8 * g + 4 * hh);
#pragma unroll
                for (int nt = 0; nt < 4; ++nt)
#pragma unroll
                    for (int i = 0; i < 4; ++i) acc[nt][4 * g + i] *= iv[i]; }
            const float alpha_t = gvd[2 * CH + 32 * rb + l31]; float rowsum = 0.f;
#pragma unroll 1
            for (int sb = 0; sb < 4; ++sb) {
                if (d == 0 ? (sb > rb) : (sb < rb)) continue;
                f32x16 xx;
#pragma unroll
                for (int i = 0; i < 16; ++i) xx[i] = 0.f;
#pragma unroll
                for (int kk = 0; kk < 4; ++kk) { const bf16x8 kf = *(const LAS bf16x8*)(Ks + (32 * sb + l31) * QP + 16 * kk + 8 * hh); xx = MFMA32(kf, qf[kk], xx); }
                const int tl = 32 * rb + l31;
#pragma unroll
                for (int g = 0; g < 4; ++g) { const f32x4 bv = *(const LAS f32x4*)(gvd + 1 * CH + 32 * sb + 8 * g + 4 * hh);
#pragma unroll
                    for (int i = 0; i < 4; ++i) { const int sl = 32 * sb + 8 * g + 4 * hh + i; const bool valid = d == 0 ? (sl <= tl) : (sl >= tl);
                        const float p = valid ? __expf(alpha_t + bv[i]) * xx[4 * g + i] : 0.f; xx[4 * g + i] = p; rowsum += p; } }
#pragma unroll
                for (int ks = 0; ks < 2; ++ks) {
                    v4u pw; pw.x = cvtpk(xx[8 * ks + 0], xx[8 * ks + 1]); pw.y = cvtpk(xx[8 * ks + 2], xx[8 * ks + 3]); pw.z = cvtpk(xx[8 * ks + 4], xx[8 * ks + 5]); pw.w = cvtpk(xx[8 * ks + 6], xx[8 * ks + 7]);
                    const bf16x8 pa = __builtin_bit_cast(bf16x8, pw);
#pragma unroll
                    for (int nt = 0; nt < 4; ++nt) { const LAS bf16* vp = VTs + (32 * nt + l31) * VP + 32 * sb + 16 * ks + 4 * hh;
                        const v2u lo = *(const LAS v2u*)vp, hi2 = *(const LAS v2u*)(vp + 8); v4u vw; vw.x = lo.x; vw.y = lo.y; vw.z = hi2.x; vw.w = hi2.y;
                        acc[nt] = MFMA32(pa, __builtin_bit_cast(bf16x8, vw), acc[nt]); } }
            }
            rowsum += __shfl_xor(rowsum, 32);
            float qn = 0.f;
#pragma unroll
            for (int i = 0; i < 32; ++i) qn += bf2f(Qs[(32 * rb + l31) * QP + 32 * hh + i]) * NPp[it * DK + 32 * hh + i];
            qn += __shfl_xor(qn, 32);
            { const float denom = gvd[3 * CH + 32 * rb + l31] * qn + rowsum; gv[(d * 6 + 5) * CH + 32 * rb + l31] = 1.0f / fmaxf(fabsf(denom), gvd[4 * CH + 32 * rb + l31]); }
            LDS_WAIT();
#pragma unroll
            for (int g = 0; g < 4; ++g) { const f32x4 dv4 = *(const LAS f32x4*)(gvd + 5 * CH + 32 * rb + 8 * g + 4 * hh);
#pragma unroll
                for (int nt = 0; nt < 4; ++nt)
#pragma unroll
                    for (int i = 0; i < 4; ++i) acc[nt][4 * g + i] *= dv4[i]; }
            if (d == 1) {
#pragma unroll
                for (int nt = 0; nt < 4; ++nt)
#pragma unroll
                    for (int i = 0; i < 16; ++i) HB[(32 * rb + (i & 3) + 8 * (i >> 2) + 4 * hh) * HP + 32 * nt + l31] = acc[nt][i]; }
            __syncthreads();
            if (d == 0) {
#pragma unroll
                for (int nt = 0; nt < 4; ++nt)
#pragma unroll
                    for (int i = 0; i < 16; ++i) HB[(32 * rb + (i & 3) + 8 * (i >> 2) + 4 * hh) * HP + 32 * nt + l31] += acc[nt][i]; }
            __syncthreads();
            { const int t = tid >> 2, dvq = tid & 3; f32x4 hv[8]; float sq = 0.f;
#pragma unroll
                for (int j = 0; j < 8; ++j) { hv[j] = *(const LAS f32x4*)(HB + t * HP + dvq * 32 + 4 * j); sq += (hv[j].x * hv[j].x + hv[j].y * hv[j].y) + (hv[j].z * hv[j].z + hv[j].w * hv[j].w); }
                sq += __shfl_xor(sq, 1); sq += __shfl_xor(sq, 2);
                const float r = 1.0f / sqrtf(sq * (1.f / DV) + EPS);
#pragma unroll
                for (int j8 = 0; j8 < 4; ++j8) { float o[8]; ld8(Z + (size_t)(r0 + t) * NZ + Z_O + h * DV + dvq * 32 + j8 * 8, o);
                    const f32x4 g0 = *(const f32x4*)(hgain + h * DV + dvq * 32 + j8 * 8), g1 = *(const f32x4*)(hgain + h * DV + dvq * 32 + j8 * 8 + 4);
                    const f32x4 a0 = hv[2 * j8], a1 = hv[2 * j8 + 1]; float y[8];
#pragma unroll
                    for (int i = 0; i < 4; ++i) { y[i] = a0[i] * r * g0[i] / (1.0f + __expf(-o[i])); y[4 + i] = a1[i] * r * g1[i] / (1.0f + __expf(-o[4 + i])); }
                    v4u w; w.x = pk2(y[0], y[1]); w.y = pk2(y[2], y[3]); w.z = pk2(y[4], y[5]); w.w = pk2(y[6], y[7]);
                    *(v4u*)(Y + (size_t)(r0 + t) * D + 512 + h * DV + dvq * 32 + j8 * 8) = w; } }
        }
    }
    SEAM(7);
    }
    if (IN(8)) {
        pg8::Gemm g{Y, WMO, M, D, D}; pg8::StaticOrder S; S.init(M, D, G, (int)blockIdx.x);
        pg8::EpiBf16 E{H, D};
        pg8::gemm_phase<pg8::EpiBf16, pg8::StaticOrder, true, true>(lds, g, S, E);
    }
    SEAM(8);
    if (IN(9)) norm_rows<true, true>(out, H, args.in[6], 1.0f, out, args.in[14], XN, gw, NGW, lane);
    SEAM(9);
    if (IN(10)) {
        pg8::Gemm g{XN, W2I, M, 2 * FF, D}; pg8::StaticOrder S; S.init(M, 2 * FF, G, (int)blockIdx.x);
        pg8::EpiSwiglu E{ACT, FF};
        pg8::gemm_phase<pg8::EpiSwiglu, pg8::StaticOrder, true, true>(lds, g, S, E);
    }
    SEAM(10);
    if (IN(11)) {
        pg8::Gemm g{ACT, W2O, M, D, FF}; pg8::StaticOrder S; S.init(M, D, G, (int)blockIdx.x);
        pg8::EpiBf16 E{H, D};
        pg8::gemm_phase<pg8::EpiBf16, pg8::StaticOrder, true, true>(lds, g, S, E);
    }
    SEAM(11);
    if (IN(12)) norm_rows<true, false>(out, H, args.in[15], 0.5f, out, nullptr, nullptr, gw, NGW, lane);
#undef IN
#undef SEAM
}

extern "C" void kernel_launch(void* const* d_in, const int* in_sizes, int n_in, void* d_out, int out_size, void* d_ws, size_t ws_size, hipStream_t stream) {
    static int grid = 0;
    if (grid == 0) {
        if (n_in != 18 || in_sizes[0] != M * D || out_size != M * D || ws_size < WS_END) { fprintf(stderr, "kernel_launch: unexpected shapes (n_in %d, in0 %d, out %d, ws %zu)\n", n_in, n_in > 0 ? in_sizes[0] : -1, out_size, ws_size); grid = -1; return; }
        int dev = 0, cus = 0, per_cu = 0;
        if (hipGetDevice(&dev) != hipSuccess || hipDeviceGetAttribute(&cus, hipDeviceAttributeMultiprocessorCount, dev) != hipSuccess) { grid = -1; return; }
        if (hipFuncSetAttribute((const void*)fwd, hipFuncAttributeMaxDynamicSharedMemorySize, LDS_BYTES) != hipSuccess) { fprintf(stderr, "kernel_launch: hipFuncSetAttribute failed\n"); grid = -1; return; }
        if (hipOccupancyMaxActiveBlocksPerMultiprocessor(&per_cu, (const void*)fwd, NTHR, LDS_BYTES) != hipSuccess || per_cu < 1) { fprintf(stderr, "kernel_launch: occupancy query says %d blocks per CU\n", per_cu); grid = -1; return; }
        grid = cus;
    }
    if (grid < 0) return;
    if (hipMemsetAsync(d_ws, 0, 65536, stream) != hipSuccess) { fprintf(stderr, "kernel_launch: memset of the barrier words failed\n"); return; }
    Args a{};
    for (int i = 0; i < 18; ++i) a.in[i] = (const float*)d_in[i];
    a.out = (float*)d_out; a.ws = (unsigned char*)d_ws;
    const int cuts[] = MK_CUTS;
    const int ncuts = (int)(sizeof(cuts) / sizeof(cuts[0]));
    for (int li = 0; li + 1 < ncuts; ++li) {
        a.ph_lo = cuts[li]; a.ph_hi = cuts[li + 1];
        void* kargs[] = {&a};
        const hipError_t le = hipLaunchCooperativeKernel((const void*)fwd, dim3(grid), dim3(NTHR), kargs, LDS_BYTES, stream);
        if (le != hipSuccess) { fprintf(stderr, "kernel_launch: cooperative launch %d failed: %s (grid %d)\n", li, hipGetErrorString(le), grid); break; }
    }
}
```

```cpp
#include <hip/hip_runtime.h>
#include <hip/hip_cooperative_groups.h>
#include <cstdio>
#include <cstdint>
namespace cg = cooperative_groups;
namespace pg8 {
#define PG8_LAS __attribute__((address_space(3)))
typedef unsigned short bf16_t;
typedef short bf16x8 __attribute__((ext_vector_type(8)));
typedef float f32x4 __attribute__((ext_vector_type(4)));
typedef unsigned u32x4 __attribute__((ext_vector_type(4)));
constexpr int BM = 256, BK = 64, HALF = 128, HTB = HALF * BK * 2  , STAGE_BYTES = 8 * HTB, NXCD = 8, WGM = 8;

__host__ __device__ __forceinline__ int lds_byte(int r, int c) { const int st = (r >> 4) * 2 + (c >> 5), rr = r & 15, cc = c & 31, ob = rr * 64 + cc * 2; return st * 1024 + (ob ^ (((ob >> 9) & 1) << 5)); }
__host__ __device__ __forceinline__ void stage_rc(int b, int& R, int& C) { const int st = b / 1024, sb = b % 1024, swz = sb ^ (((sb >> 9) & 1) << 5); R = (st >> 1) * 16 + swz / 64; C = (st & 1) * 32 + (swz % 64) / 2; }
__host__ __device__ __forceinline__ int perm32(int rho) { const int n = rho >> 4, i = rho & 15; return 8 * (i >> 2) + 4 * n + (i & 3); }

struct Unit { int pm, pn; };
struct Gemm { const bf16_t* A; const bf16_t* Bt; int M, N, K; };

struct StaticOrder {
    int nM, nN, nwg, G, c;
    __host__ __device__ void init(int M, int N, int G_, int c_) { nM = M / BM; nN = N / BM; nwg = nM * nN; G = G_; c = c_; }
    __host__ __device__ bool next(int i, Unit& u) const {
        const long L = (long)i * G + c; if (L >= nwg) return false;
        int wgid = (int)L; { const int q = nwg / NXCD, r = nwg % NXCD, xcd = wgid % NXCD, off = wgid / NXCD; wgid = (xcd < r ? xcd * (q + 1) : r * (q + 1) + (xcd - r) * q) + off; }
        const int nig = WGM * nN, gid = wgid / nig, fm = gid * WGM, gsz = (nM - fm) < WGM ? (nM - fm) : WGM;
        u.pm = fm + ((wgid % nig) % gsz); u.pn = (wgid % nig) / gsz; return true;
    }
    __device__ __forceinline__ void a_ready(const Unit&) const {}
    __device__ __forceinline__ void done(const Unit&) const {}
};

__device__ __forceinline__ unsigned cvt_pk_bf16(float lo, float hi) { unsigned r; asm volatile("v_cvt_pk_bf16_f32 %0, %1, %2" : "=v"(r) : "v"(lo), "v"(hi)); return r; }
typedef float f32x2 __attribute__((ext_vector_type(2)));
struct EpiBf16 {
    static constexpr bool PERM = true, AFTER_DRAIN = false;
    bf16_t* O; int ldc;
    __device__ __forceinline__ void operator()(const f32x4 (&acc)[2][2][4][2], const Unit& u, int wr, int wc, int fr, int fq) const {
        const int row0 = u.pm * BM + wr * 64 + fr; const int col0 = u.pn * BM + wc * 32 + 8 * fq;
#pragma unroll
        for (int ai = 0; ai < 2; ++ai)
#pragma unroll
            for (int m = 0; m < 4; ++m) { bf16_t* rowp = O + (size_t)(row0 + ai * HALF + m * 16) * ldc + col0;
#pragma unroll
                for (int bj = 0; bj < 2; ++bj) { const f32x4 v0 = acc[ai][bj][m][0], v1 = acc[ai][bj][m][1];
                    u32x4 w; w.x = cvt_pk_bf16(v0[0], v0[1]); w.y = cvt_pk_bf16(v0[2], v0[3]); w.z = cvt_pk_bf16(v1[0], v1[1]); w.w = cvt_pk_bf16(v1[2], v1[3]);
                    *(u32x4*)(rowp + bj * HALF) = w; } }
    }
};
__device__ __forceinline__ float silu_mul(float g, float u) { const float e = __expf(-g); return g * u * __builtin_amdgcn_rcpf(1.0f + e); }
struct EpiSwiglu {
    static constexpr bool PERM = true, AFTER_DRAIN = false;
    bf16_t* O; int ldc;
    __device__ __forceinline__ void operator()(const f32x4 (&acc)[2][2][4][2], const Unit& u, int wr, int wc, int fr, int fq) const {
        const int row0 = u.pm * BM + wr * 64 + fr; const int col0 = u.pn * HALF + wc * 32 + 8 * fq;
#pragma unroll
        for (int ai = 0; ai < 2; ++ai)
#pragma unroll
            for (int m = 0; m < 4; ++m) { bf16_t* rowp = O + (size_t)(row0 + ai * HALF + m * 16) * ldc + col0;
                const f32x4 g0 = acc[ai][0][m][0], g1 = acc[ai][0][m][1], u0 = acc[ai][1][m][0], u1 = acc[ai][1][m][1];
                u32x4 w;
                w.x = cvt_pk_bf16(silu_mul(g0[0], u0[0]), silu_mul(g0[1], u0[1])); w.y = cvt_pk_bf16(silu_mul(g0[2], u0[2]), silu_mul(g0[3], u0[3]));
                w.z = cvt_pk_bf16(silu_mul(g1[0], u1[0]), silu_mul(g1[1], u1[1])); w.w = cvt_pk_bf16(silu_mul(g1[2], u1[2]), silu_mul(g1[3], u1[3]));
                *(u32x4*)rowp = w; }
    }
};
template <class Epi, class Sched, bool ALIGN_EPI = false, bool SP2 = false>
__device__ __forceinline__ void gemm_phase(PG8_LAS unsigned char* lds, const Gemm g, const Sched& S, const Epi& E) {
    const int tid = threadIdx.x, wid = __builtin_amdgcn_readfirstlane(tid >> 6), lane = tid & 63, wr = wid >> 2, wc = wid & 3, fr = lane & 15, fq = lane >> 4;
    const int K = g.K, nt = K / BK;
    unsigned voffA[2], voffB[2];
#pragma unroll
    for (int i = 0; i < 2; ++i) { int R, C; stage_rc(tid * 16 + i * 8192, R, C); const int Rb = Epi::PERM ? ((R & ~31) + perm32(R & 31)) : R;
        voffA[i] = (unsigned)(R * K + C) * 2u; voffB[i] = (unsigned)(Rb * K + C) * 2u; }
    const size_t kstep = (size_t)(BK * 2);
    const size_t hstep = (size_t)HALF * K * 2;
    const size_t tstep = 2 * hstep;
    const unsigned ldsw = (unsigned)wid * 1024u;
    const int aoff = lds_byte(wr * 64 + fr, fq * 8), boff = lds_byte(wc * 32 + fr, fq * 8);
#define PG8_SA(b, h) (((b) * 2 + (h)) * HTB)
#define PG8_SB(b, h) ((4 + (b) * 2 + (h)) * HTB)
#define PG8_STAGE(bufoff, gbase, voff) do { _Pragma("unroll") for (int _i = 0; _i < 2; ++_i) \
        __builtin_amdgcn_global_load_lds((const unsigned*)((const char*)(gbase) + (voff)[_i]), (PG8_LAS unsigned*)(lds + (bufoff) + ldsw + _i * 8192), 16, 0, 0); } while (0)
#define PG8_LDA(dst, b, h) do { _Pragma("unroll") for (int m = 0; m < 4; ++m) _Pragma("unroll") for (int k = 0; k < 2; ++k) dst[m][k] = *(const PG8_LAS bf16x8*)(lds + PG8_SA(b, h) + aoff + m * 2048 + k * 1024); } while (0)
#define PG8_LDB(dst, b, h) do { _Pragma("unroll") for (int n = 0; n < 2; ++n) _Pragma("unroll") for (int k = 0; k < 2; ++k) dst[n][k] = *(const PG8_LAS bf16x8*)(lds + PG8_SB(b, h) + boff + n * 2048 + k * 1024); } while (0)
#define PG8_MMA(ai, bj, At, Bt) do { __builtin_amdgcn_s_setprio(1); _Pragma("unroll") for (int m = 0; m < 4; ++m) _Pragma("unroll") for (int n = 0; n < 2; ++n) _Pragma("unroll") for (int k = 0; k < 2; ++k) \
        acc[ai][bj][m][n] = __builtin_amdgcn_mfma_f32_16x16x32_bf16(Bt[n][k], At[m][k], acc[ai][bj][m][n], 0, 0, 0); __builtin_amdgcn_s_setprio(0); } while (0)
#define PG8_WAIT_V(n) asm volatile("s_waitcnt vmcnt(" #n ")" ::: "memory")
#define PG8_WAIT_L(n) asm volatile("s_waitcnt lgkmcnt(" #n ")" ::: "memory")
#define PG8_BAR __builtin_amdgcn_s_barrier()
#define PG8_SCHED __builtin_amdgcn_sched_barrier(0)
    Unit cur, nxt; int ui = 0;
    if (!S.next(0, cur)) return;
    f32x4 acc[2][2][4][2];
#pragma unroll
    for (int a = 0; a < 2; ++a)
#pragma unroll
        for (int b = 0; b < 2; ++b)
#pragma unroll
            for (int m = 0; m < 4; ++m)
#pragma unroll
                for (int n = 0; n < 2; ++n) acc[a][b][m][n] = (f32x4){0.f, 0.f, 0.f, 0.f};
    bf16x8 At[4][2], B0[2][2], B1[2][2];
    const char* cA = (const char*)g.A + (size_t)cur.pm * tstep; const char* cB = (const char*)g.Bt + (size_t)cur.pn * tstep;
    S.a_ready(cur);
    if constexpr (SP2) {
        PG8_STAGE(PG8_SB(0, 0), cB, voffB); PG8_STAGE(PG8_SB(0, 1), cB + hstep, voffB); PG8_STAGE(PG8_SA(0, 0), cA, voffA); PG8_STAGE(PG8_SA(0, 1), cA + hstep, voffA);
        if (wr == 1) PG8_BAR;
        PG8_WAIT_V(2); PG8_BAR;
        PG8_STAGE(PG8_SB(1, 0), cB + kstep, voffB); PG8_STAGE(PG8_SA(1, 0), cA + kstep, voffA); PG8_STAGE(PG8_SB(1, 1), cB + hstep + kstep, voffB);
        PG8_WAIT_V(6); PG8_BAR;
    } else {
        PG8_STAGE(PG8_SB(0, 0), cB, voffB); PG8_STAGE(PG8_SA(0, 0), cA, voffA); PG8_STAGE(PG8_SB(0, 1), cB + hstep, voffB); PG8_STAGE(PG8_SA(0, 1), cA + hstep, voffA);
        if (wr == 1) PG8_BAR;
        PG8_WAIT_V(4); PG8_BAR;
        PG8_STAGE(PG8_SB(1, 0), cB + kstep, voffB); PG8_STAGE(PG8_SA(1, 0), cA + kstep, voffA); PG8_STAGE(PG8_SB(1, 1), cB + hstep + kstep, voffB);
        PG8_WAIT_V(6); PG8_BAR;
    }
    for (;;) {
        const bool has_next = S.next(ui + 1, nxt);
        const char* nA = has_next ? (const char*)g.A + (size_t)nxt.pm * tstep : cA; const char* nB = has_next ? (const char*)g.Bt + (size_t)nxt.pn * tstep : cB;
        for (int t = 0; t < nt; t += 2) {
            const bool last = (t == nt - 2);
            const char* a1 = cA + (size_t)(t + 1) * kstep;
            const char* a2 = last ? nA : cA + (size_t)(t + 2) * kstep; const char* b2 = last ? nB : cB + (size_t)(t + 2) * kstep;
            const char* a3 = a2 + kstep; const char* b3 = b2 + kstep;
            if (last && has_next) S.a_ready(nxt);
            if constexpr (SP2) {
            PG8_LDB(B0, 0, 0); PG8_LDB(B1, 0, 1); PG8_SCHED; PG8_LDA(At, 0, 0); PG8_STAGE(PG8_SA(1, 1), a1 + hstep, voffA);
            PG8_WAIT_V(8); PG8_WAIT_L(0); PG8_BAR; PG8_MMA(0, 0, At, B0); PG8_MMA(0, 1, At, B1); PG8_BAR; PG8_SCHED;
            PG8_LDA(At, 0, 1); PG8_STAGE(PG8_SB(0, 0), b2, voffB); PG8_STAGE(PG8_SB(0, 1), b2 + hstep, voffB); PG8_STAGE(PG8_SA(0, 0), a2, voffA);
            PG8_WAIT_V(8); PG8_WAIT_L(0); PG8_BAR; PG8_MMA(1, 0, At, B0); PG8_MMA(1, 1, At, B1); PG8_BAR; PG8_SCHED;
            PG8_LDB(B0, 1, 0); PG8_LDB(B1, 1, 1); PG8_SCHED; PG8_LDA(At, 1, 0); PG8_STAGE(PG8_SA(0, 1), a2 + hstep, voffA);
            PG8_WAIT_V(8); PG8_WAIT_L(0); PG8_BAR; PG8_MMA(0, 0, At, B0); PG8_MMA(0, 1, At, B1); PG8_BAR; PG8_SCHED;
            PG8_LDA(At, 1, 1); PG8_STAGE(PG8_SB(1, 0), b3, voffB); PG8_STAGE(PG8_SB(1, 1), b3 + hstep, voffB); PG8_STAGE(PG8_SA(1, 0), a3, voffA);
            PG8_WAIT_V(8); PG8_WAIT_L(0); PG8_BAR; PG8_MMA(1, 0, At, B0); PG8_MMA(1, 1, At, B1); PG8_BAR; PG8_SCHED;
            } else {
            PG8_LDB(B0, 0, 0); PG8_SCHED; PG8_LDA(At, 0, 0); PG8_STAGE(PG8_SA(1, 1), a1 + hstep, voffA);
            PG8_WAIT_L(8); PG8_BAR; PG8_WAIT_L(0); PG8_MMA(0, 0, At, B0); PG8_BAR; PG8_SCHED;
            PG8_LDB(B1, 0, 1); PG8_STAGE(PG8_SB(0, 0), b2, voffB);
            PG8_BAR; PG8_WAIT_L(0); PG8_MMA(0, 1, At, B1); PG8_BAR;
            PG8_LDA(At, 0, 1); PG8_STAGE(PG8_SA(0, 0), a2, voffA);
            PG8_BAR; PG8_WAIT_L(0); PG8_MMA(1, 0, At, B0); PG8_BAR; PG8_SCHED;
            PG8_STAGE(PG8_SB(0, 1), b2 + hstep, voffB);
            PG8_WAIT_V(6); PG8_BAR; PG8_MMA(1, 1, At, B1); PG8_BAR;
            PG8_LDB(B0, 1, 0); PG8_SCHED; PG8_LDA(At, 1, 0); PG8_STAGE(PG8_SA(0, 1), a2 + hstep, voffA);
            PG8_WAIT_L(8); PG8_BAR; PG8_WAIT_L(0); PG8_MMA(0, 0, At, B0); PG8_BAR; PG8_SCHED;
            PG8_LDB(B1, 1, 1); PG8_STAGE(PG8_SB(1, 0), b3, voffB);
            PG8_BAR; PG8_WAIT_L(0); PG8_MMA(0, 1, At, B1); PG8_BAR;
            PG8_LDA(At, 1, 1); PG8_STAGE(PG8_SA(1, 0), a3, voffA);
            PG8_BAR; PG8_WAIT_L(0); PG8_MMA(1, 0, At, B0); PG8_BAR; PG8_SCHED;
            PG8_STAGE(PG8_SB(1, 1), b3 + hstep, voffB);
            PG8_WAIT_V(6); PG8_BAR; PG8_MMA(1, 1, At, B1); PG8_BAR;
            }
        }
        if constexpr (ALIGN_EPI) { if (wr == 0) PG8_BAR; }
        if constexpr (!Epi::AFTER_DRAIN) { E(acc, cur, wr, wc, fr, fq); S.done(cur); }
        if (!has_next) break;
#pragma unroll
        for (int a = 0; a < 2; ++a)
#pragma unroll
            for (int b = 0; b < 2; ++b)
#pragma unroll
                for (int m = 0; m < 4; ++m)
#pragma unroll
                    for (int n = 0; n < 2; ++n) acc[a][b][m][n] = (f32x4){0.f, 0.f, 0.f, 0.f};
        cur = nxt; cA = nA; cB = nB; ++ui;
        if constexpr (ALIGN_EPI) { if (wr == 1) PG8_BAR; }
    }
    PG8_WAIT_V(0);
    if constexpr (!ALIGN_EPI) { if (wr == 0) PG8_BAR; }
    PG8_BAR;
    if constexpr (Epi::AFTER_DRAIN) { E.fused(acc, cur, wr, wc, fr, fq, lds, wid, lane); S.done(cur); }
#undef PG8_SA
#undef PG8_SB
#undef PG8_STAGE
#undef PG8_LDA
#undef PG8_LDB
#undef PG8_MMA
#undef PG8_WAIT_V
#undef PG8_WAIT_L
#undef PG8_BAR
#undef PG8_SCHED
}
}

constexpr int NWAVES = 8, NTHR = NWAVES * 64;
constexpr int BATCH = 4, SEQ = 4096, D = 1024, FF = 2816, M = BATCH * SEQ;
constexpr int NZ = 3072, WINC = 3088;
constexpr int NH = 4, DK = 64, DV = 128, CH = 128, NC = SEQ / CH;
constexpr int Z_BG = 0, Z_CG = 512, Z_HC = 1024, Z_Q = 1536, Z_K = 1792, Z_V = 2048, Z_O = 2560;
constexpr float EPS = 1e-6f, NEG_INF = -1e30f;
constexpr int N_PHASES = 13;
#ifndef REP_5
#define REP_5 1
#endif
#ifndef REP_7
#define REP_7 1
#endif
#ifndef REP_0
#define REP_0 1
#endif
#ifndef REP_1
#define REP_1 1
#endif
#ifndef REP_3
#define REP_3 1
#endif
#ifndef REP_M
#define REP_M 1
#endif
#ifndef SYNC_REP
#define SYNC_REP 1
#endif
#ifndef MK_CUTS
#define MK_CUTS {0, N_PHASES}
#endif

constexpr size_t MiB = 1u << 20;
constexpr size_t WS_W1I = 1 * MiB, WS_W1O = 12 * MiB, WS_WMI = 35 * MiB / 2, WS_WMO = 47 * MiB / 2, WS_W2I = 51 * MiB / 2, WS_W2O = 73 * MiB / 2, WS_WG = 42 * MiB;
constexpr size_t WS_XN = 44 * MiB;
constexpr size_t WS_ACT = 76 * MiB;
constexpr size_t WS_H = 172 * MiB;
constexpr size_t WS_G = 204 * MiB;
constexpr size_t WS_CC = 205 * MiB;
constexpr size_t WS_CP = 237 * MiB;
constexpr size_t WS_SM = 253 * MiB;
constexpr size_t WS_END = 254 * MiB;
constexpr int LDS_BYTES = 147456;

#define GAS __attribute__((address_space(1)))
#define LAS __attribute__((address_space(3)))
typedef unsigned short bf16;
typedef unsigned v4u __attribute__((ext_vector_type(4)));
typedef unsigned v2u __attribute__((ext_vector_type(2)));
typedef float f32x4 __attribute__((ext_vector_type(4)));
typedef short bf16x8 __attribute__((ext_vector_type(8)));
#define LDS_WAIT() asm volatile("s_waitcnt lgkmcnt(0)" ::: "memory")
__device__ __forceinline__ unsigned f2bf(float f) { unsigned u = __builtin_bit_cast(unsigned, f); return (u + 0x7fffu + ((u >> 16) & 1u)) >> 16; }
__device__ __forceinline__ unsigned pk2(float lo, float hi) { return f2bf(lo) | (f2bf(hi) << 16); }
__device__ __forceinline__ float bflo(unsigned w) { return __uint_as_float(w << 16); }
__device__ __forceinline__ float bfhi(unsigned w) { return __uint_as_float(w & 0xffff0000u); }
__device__ __forceinline__ float bf2f(bf16 h) { return __uint_as_float((unsigned)h << 16); }
typedef float f32x16 __attribute__((ext_vector_type(16)));
typedef float f32x2_t __attribute__((ext_vector_type(2))); typedef __bf16 bf16x2_t __attribute__((ext_vector_type(2)));
__device__ __forceinline__ unsigned cvtpk(float lo, float hi) { f32x2_t v = {lo, hi}; bf16x2_t b = __builtin_convertvector(v, bf16x2_t); return __builtin_bit_cast(unsigned, b); }
#define MFMA32(a, b, c) __builtin_amdgcn_mfma_f32_32x32x16_bf16((a), (b), (c), 0, 0, 0)
__device__ __forceinline__ float wave_sum(float v) {
#pragma unroll
    for (int o = 1; o < 64; o <<= 1) v += __shfl_xor(v, o);
    return v;
}


__device__ __forceinline__ float lane_scan_sum(float s, int lane) {
#pragma unroll
    for (int o = 1; o < 64; o <<= 1) { const float v = __shfl_up(s, o); if (lane >= o) s += v; }
    return s;
}
__device__ __forceinline__ float lane_scan_max(float s, int lane) {
#pragma unroll
    for (int o = 1; o < 64; o <<= 1) { const float v = __shfl_up(s, o); if (lane >= o) s = fmaxf(s, v); }
    return s;
}
__device__ __forceinline__ float wave_max(float v) {
#pragma unroll
    for (int o = 1; o < 64; o <<= 1) v = fmaxf(v, __shfl_xor(v, o));
    return v;
}

__device__ __forceinline__ void transpose_item(const float* __restrict__ W, int ldw, int k0, int c0, bf16* __restrict__ WT, int K, int r0, LAS float* scr, int lane) {
#pragma unroll 8
    for (int i = 0; i < 32; ++i) { const int kk = 2 * i + (lane >> 5); scr[kk * 33 + (lane & 31)] = W[(size_t)(k0 + kk) * ldw + c0 + (lane & 31)]; }
    LDS_WAIT(); asm volatile("" ::: "memory");
    const int c = lane & 7;
#pragma unroll
    for (int j = 0; j < 4; ++j) { const int n = (lane >> 3) + 8 * j; const LAS float* s = scr + (8 * c) * 33 + n;
        v4u o; o.x = pk2(s[0 * 33], s[1 * 33]); o.y = pk2(s[2 * 33], s[3 * 33]); o.z = pk2(s[4 * 33], s[5 * 33]); o.w = pk2(s[6 * 33], s[7 * 33]);
        *(v4u*)(WT + (size_t)(r0 + n) * K + k0 + 8 * c) = o; }
    LDS_WAIT(); asm volatile("" ::: "memory");
}
__device__ __forceinline__ int swiglu_row(int c0) { const int s = c0 / FF, j = c0 % FF; return 256 * (j / 128) + 128 * s + (j % 128); }

template <bool HAS_H, bool HAS_NEXT>
__device__ __forceinline__ void norm_rows(const float* xin, const bf16* H, const float* gpost, float scale, float* xout, const float* gpre, bf16* XN, int gw, int NGW, int lane) {
    f32x4 gp[4], gn[4];
#pragma unroll
    for (int j = 0; j < 4; ++j) { if (HAS_H) gp[j] = ((const f32x4*)gpost)[lane + 64 * j]; if (HAS_NEXT) gn[j] = ((const f32x4*)gpre)[lane + 64 * j]; }
    for (int m = gw; m < M; m += NGW) {
        f32x4 v[4];
#pragma unroll
        for (int j = 0; j < 4; ++j) v[j] = ((const f32x4*)(xin + (size_t)m * D))[lane + 64 * j];
        if (HAS_H) {
            f32x4 hv[4]; float s = 0.f;
#pragma unroll
            for (int j = 0; j < 4; ++j) { const v2u w = ((const v2u*)(H + (size_t)m * D))[lane + 64 * j]; hv[j] = (f32x4){bflo(w.x), bfhi(w.x), bflo(w.y), bfhi(w.y)};
                s += (hv[j].x * hv[j].x + hv[j].y * hv[j].y) + (hv[j].z * hv[j].z + hv[j].w * hv[j].w); }
            const float rh = scale / sqrtf(wave_sum(s) * (1.f / D) + EPS);
#pragma unroll
            for (int j = 0; j < 4; ++j) { v[j] = v[j] + hv[j] * gp[j] * rh; ((f32x4*)(xout + (size_t)m * D))[lane + 64 * j] = v[j]; }
        }
        if (HAS_NEXT) {
            float s = 0.f;
#pragma unroll
            for (int j = 0; j < 4; ++j) s += (v[j].x * v[j].x + v[j].y * v[j].y) + (v[j].z * v[j].z + v[j].w * v[j].w);
            const float r = 1.0f / sqrtf(wave_sum(s) * (1.f / D) + EPS);
#pragma unroll
            for (int j = 0; j < 4; ++j) { const f32x4 o = v[j] * gn[j] * r; v2u w; w.x = pk2(o.x, o.y); w.y = pk2(o.z, o.w); ((v2u*)(XN + (size_t)m * D))[lane + 64 * j] = w; }
        }
    }
}

__device__ __forceinline__ void ld8(const bf16* p, float (&o)[8]) { const v4u w = *(const v4u*)p; o[0] = bflo(w.x); o[1] = bfhi(w.x); o[2] = bflo(w.y); o[3] = bfhi(w.y); o[4] = bflo(w.z); o[5] = bfhi(w.z); o[6] = bflo(w.w); o[7] = bfhi(w.w); }

#define XB_TMO      128
#define XB_XCNT(j)  (256  + 64 * (j))
#define XB_XSUB(j)  (1280 + 64 * (j))
#define XB_XGEN(j)  (2304 + 64 * (j))
#define XB_TOP      3328
#define XB_TOPGEN   3392
#define XCD_BAR_WORDS 3456
#define XB_SPIN_CAP (1u << 18)

__device__ __forceinline__ unsigned xb_ld(unsigned* p)              { return __hip_atomic_load(p, __ATOMIC_RELAXED, __HIP_MEMORY_SCOPE_AGENT); }
__device__ __forceinline__ unsigned xb_add(unsigned* p, unsigned v) { return __hip_atomic_fetch_add(p, v, __ATOMIC_RELAXED, __HIP_MEMORY_SCOPE_AGENT); }
__device__ __forceinline__ unsigned xb_xcc_id() { return (unsigned)__builtin_amdgcn_s_getreg((3 << 11) | 20) & 0xFu; }
#define XB_SPIN(cond, bar) do { unsigned _sp = 0; while (cond) { __builtin_amdgcn_s_sleep(1); \
    if ((++_sp & 255u) == 0u) { if (xb_ld(&(bar)[XB_TMO])) break; if (_sp > XB_SPIN_CAP) { atomicAdd(&(bar)[XB_TMO], 1u); break; } } } } while (0)

struct XcdBarrier {
    unsigned* bar; unsigned x;
    volatile LAS unsigned* st;
};

__device__ __forceinline__ XcdBarrier xcd_barrier_post(unsigned* bar, volatile LAS unsigned* st) {
    XcdBarrier b; b.bar = bar; b.x = xb_xcc_id(); b.st = st;
    if (threadIdx.x == 0) (void)xb_add(&bar[XB_XCNT(b.x)], 1u);
    return b;
}
__device__ __forceinline__ void xcd_barrier_complete(unsigned* bar, unsigned x, unsigned& nloc, unsigned& nx) {
    const unsigned G = gridDim.x * gridDim.y * gridDim.z;
    unsigned sum, cnt, mine, sp = 0u;
    for (;;) {
        sum = 0u; cnt = 0u; mine = 0u;
#pragma unroll
        for (unsigned j = 0; j < 16; ++j) { const unsigned c = xb_ld(&bar[XB_XCNT(j)]); sum += c; cnt += (c > 0u) ? 1u : 0u; mine = (j == x) ? c : mine; }
        if (sum == G) break;
        __builtin_amdgcn_s_sleep(1);
        if ((++sp & 255u) == 0u) { if (xb_ld(&bar[XB_TMO])) break; if (sp > XB_SPIN_CAP) { atomicAdd(&bar[XB_TMO], 1u); break; } }
    }
    nloc = mine > 0u ? mine : 1u; nx = cnt > 0u ? cnt : 1u;
}

__device__ __forceinline__ void xcd_barrier(const XcdBarrier& b) {
    asm volatile("s_waitcnt vmcnt(0)" ::: "memory");
    __syncthreads();
    if (threadIdx.x == 0) {
        unsigned* bar = b.bar;
        __builtin_amdgcn_s_waitcnt(0);
        unsigned nloc = b.st[0], nx = b.st[1];
        if (nloc == 0u) { xcd_barrier_complete(bar, b.x, nloc, nx); b.st[0] = nloc; b.st[1] = nx; }
        const unsigned old = xb_add(&bar[XB_XSUB(b.x)], 1u);
        const unsigned gen = old / nloc;
        if (old + 1u == (gen + 1u) * nloc) {
            __builtin_amdgcn_fence(__ATOMIC_RELEASE, "agent");
            asm volatile("s_waitcnt vmcnt(0)" ::: "memory");
            const unsigned og = xb_add(&bar[XB_TOP], 1u);
            const unsigned tg = og / nx;
            if (og + 1u == (tg + 1u) * nx) xb_add(&bar[XB_TOPGEN], 1u);
            else XB_SPIN(xb_ld(&bar[XB_TOPGEN]) == tg, bar);
            __builtin_amdgcn_fence(__ATOMIC_ACQUIRE, "agent");
            xb_add(&bar[XB_XGEN(b.x)], 1u);
            asm volatile("s_waitcnt vmcnt(0)" ::: "memory");
        } else {
            XB_SPIN(xb_ld(&bar[XB_XGEN(b.x)]) == gen, bar);
            __builtin_amdgcn_fence(__ATOMIC_ACQUIRE, "agent");
            asm volatile("s_waitcnt vmcnt(0)" ::: "memory");
        }
    }
    __syncthreads();
}

struct Args { const float* in[18]; float* out; unsigned char* ws; int ph_lo, ph_hi; };
__global__ void __launch_bounds__(NTHR, 2) fwd(Args args) {
    extern __shared__ __attribute__((aligned(16))) unsigned char lds_raw[];
    LAS unsigned char* lds = (LAS unsigned char*)lds_raw;
    cg::grid_group grid = cg::this_grid();
    const int tid = threadIdx.x, lane = tid & 63, wave = __builtin_amdgcn_readfirstlane(tid >> 6);
    const int G = gridDim.x, gw = blockIdx.x * NWAVES + wave, NGW = G * NWAVES;
    unsigned char* ws = args.ws;
    const float* x = args.in[0]; float* out = args.out;
    bf16* W1I = (bf16*)(ws + WS_W1I); bf16* W1O = (bf16*)(ws + WS_W1O); bf16* WMI = (bf16*)(ws + WS_WMI); bf16* WMO = (bf16*)(ws + WS_WMO);
    bf16* W2I = (bf16*)(ws + WS_W2I); bf16* W2O = (bf16*)(ws + WS_W2O); bf16* WGT = (bf16*)(ws + WS_WG);
    bf16* XN = (bf16*)(ws + WS_XN); bf16* Y = XN; bf16* ACT = (bf16*)(ws + WS_ACT); bf16* Z = ACT; bf16* H = (bf16*)(ws + WS_H);
    float* Gt = (float*)(ws + WS_G); float* CC = (float*)(ws + WS_CC); bf16* CP = (bf16*)(ws + WS_CP);
    float* NCc = (float*)(ws + WS_SM); float* NPp = NCc + 1024 * 64; float* GC = NPp + 1024 * 64; float* MC = GC + 1024; float* MP = MC + 1024;
    const int lo = args.ph_lo, hi = args.ph_hi;
    volatile LAS unsigned* bst = (volatile LAS unsigned*)(lds + LDS_BYTES - 64);
    if (tid < 16) bst[tid] = 0u;
    __syncthreads();
    const XcdBarrier bar = xcd_barrier_post((unsigned*)ws, bst);
#define IN(k) (lo <= (k) && (k) < hi)
#ifndef USE_CG_FIRST
#define USE_CG_FIRST 0
#endif
#define SEAM(k) do { if (IN(k) && IN((k) + 1)) { for (int sr_ = 0; sr_ < SYNC_REP; ++sr_) { if (USE_CG_FIRST && (k) == 0) grid.sync(); else xcd_barrier(bar); } } } while (0)

    if (IN(0)) {
        LAS float* scr = (LAS float*)(lds + wave * 16384);
        constexpr int I_FI = 16 * 176, I_FO = 44 * 32, I_MI = 16 * 96, I_MO = 16 * 32, NITEMS = 2 * (I_FI + I_FO) + I_MI + I_MO;
        for (int it = gw; it < NITEMS; it += NGW) {
            int r = it;
            if (r < I_FI) { const int kb = r / 176, nb = r % 176; transpose_item(args.in[3], 2 * FF, 64 * kb, 32 * nb, W1I, D, swiglu_row(32 * nb), scr, lane); continue; } r -= I_FI;
            if (r < I_FI) { const int kb = r / 176, nb = r % 176; transpose_item(args.in[16], 2 * FF, 64 * kb, 32 * nb, W2I, D, swiglu_row(32 * nb), scr, lane); continue; } r -= I_FI;
            if (r < I_FO) { const int kb = r / 32, nb = r % 32; transpose_item(args.in[4], D, 64 * kb, 32 * nb, W1O, FF, 32 * nb, scr, lane); continue; } r -= I_FO;
            if (r < I_FO) { const int kb = r / 32, nb = r % 32; transpose_item(args.in[17], D, 64 * kb, 32 * nb, W2O, FF, 32 * nb, scr, lane); continue; } r -= I_FO;
            if (r < I_MI) { const int kb = r / 96, nb = r % 96; transpose_item(args.in[7], WINC, 64 * kb, 32 * nb, WMI, D, 32 * nb, scr, lane); continue; } r -= I_MI;
            { const int kb = r / 32, nb = r % 32; transpose_item(args.in[13], D, 64 * kb, 32 * nb, WMO, D, 32 * nb, scr, lane); }
        }
        for (int e = blockIdx.x * NTHR + tid; e < 16 * D; e += G * NTHR) { const int g = e / D, k = e % D; WGT[e] = (bf16)f2bf(args.in[7][(size_t)k * WINC + NZ + g]); }
        norm_rows<false, true>(x, nullptr, nullptr, 0.f, nullptr, args.in[1], XN, gw, NGW, lane);
    }
    SEAM(0);
    if (IN(1)) {
        pg8::Gemm g{XN, W1I, M, 2 * FF, D}; pg8::StaticOrder S; S.init(M, 2 * FF, G, (int)blockIdx.x);
        pg8::EpiSwiglu E{ACT, FF};
        pg8::gemm_phase<pg8::EpiSwiglu, pg8::StaticOrder, true, true>(lds, g, S, E);
    }
    SEAM(1);
    if (IN(2)) {
        pg8::Gemm g{ACT, W1O, M, D, FF}; pg8::StaticOrder S; S.init(M, D, G, (int)blockIdx.x);
        pg8::EpiBf16 E{H, D};
        pg8::gemm_phase<pg8::EpiBf16, pg8::StaticOrder, true, true>(lds, g, S, E);
    }
    SEAM(2);
    if (IN(3)) norm_rows<true, true>(x, H, args.in[2], 0.5f, out, args.in[5], XN, gw, NGW, lane);
    SEAM(3);
    if (IN(4)) {
        const int fr = lane & 15, fq = lane >> 4;
        for (int rb = gw; rb < M / 16; rb += NGW) {
            f32x4 acc = {0.f, 0.f, 0.f, 0.f};
            const bf16* arow = XN + (size_t)(rb * 16 + fr) * D + fq * 8; const bf16* brow = WGT + (size_t)fr * D + fq * 8;
#pragma unroll 8
            for (int kk = 0; kk < D / 32; ++kk) { const bf16x8 a = *(const bf16x8*)(arow + kk * 32); const bf16x8 b = *(const bf16x8*)(brow + kk * 32);
                acc = __builtin_amdgcn_mfma_f32_16x16x32_bf16(b, a, acc, 0, 0, 0); }
            f32x4 o;
#pragma unroll
            for (int i = 0; i < 4; ++i) { const int gcol = 4 * fq + i;
                if (gcol < 8) o[i] = acc[i] + args.in[10][gcol];
                else { const float v = acc[i] + args.in[11][gcol - 8]; o[i] = fminf(v, 0.f) - log1pf(__expf(-fabsf(v))); } }
            *(f32x4*)(Gt + (size_t)(rb * 16 + fr) * 16 + 4 * fq) = o;
        }
        pg8::Gemm g{XN, WMI, M, NZ, D}; pg8::StaticOrder S; S.init(M, NZ, G, (int)blockIdx.x);
        pg8::EpiBf16 E{Z, NZ};
        pg8::gemm_phase<pg8::EpiBf16, pg8::StaticOrder, true, true>(lds, g, S, E);
    }
    SEAM(4);
    for (int rep_m = 0; rep_m < REP_M; ++rep_m) {
    for (int rep5 = 0; rep5 < REP_5; ++rep5)
    if (IN(5)) {
        {
        constexpr int VP = 132;
        LAS bf16* VTs = (LAS bf16*)lds; LAS bf16* KeT = VTs + DV * VP;
        LAS float* ev = (LAS float*)(KeT + 2 * DK * VP);
        const int l31 = lane & 31, hh = lane >> 5, d = wave >> 2, dvb = wave & 3;
        for (int it2 = blockIdx.x; it2 < BATCH * NH * NC; it2 += G) {
            const int b = it2 >> 7, h = (it2 >> 5) & 3, c = it2 & 31, r0 = b * SEQ + c * CH;
            __syncthreads();
#pragma unroll
            for (int j = 0; j < 4; ++j) { const int e = tid + NTHR * j, sr = e & 127, c16 = e >> 7;
                const v4u w = *(const v4u*)(Z + (size_t)(r0 + sr) * NZ + Z_V + h * DV + c16 * 8); LAS bf16* vp = VTs + (c16 * 8) * VP + sr;
                vp[0 * VP] = (bf16)(w.x & 0xffffu); vp[1 * VP] = (bf16)(w.x >> 16); vp[2 * VP] = (bf16)(w.y & 0xffffu); vp[3 * VP] = (bf16)(w.y >> 16);
                vp[4 * VP] = (bf16)(w.z & 0xffffu); vp[5 * VP] = (bf16)(w.z >> 16); vp[6 * VP] = (bf16)(w.w & 0xffffu); vp[7 * VP] = (bf16)(w.w >> 16); }
            if (wave < 2) {
                const int gd = wave, itg = ((gd * BATCH + b) * NH + h) * NC + c;
                const int t0 = gd ? 127 - 2 * lane : 2 * lane, t1 = gd ? 126 - 2 * lane : 2 * lane + 1;
                const float lf0 = Gt[(size_t)(r0 + t0) * 16 + 8 + gd * 4 + h], lf1 = Gt[(size_t)(r0 + t1) * 16 + 8 + gd * 4 + h];
                const float li0 = Gt[(size_t)(r0 + t0) * 16 + gd * 4 + h], li1 = Gt[(size_t)(r0 + t1) * 16 + gd * 4 + h];
                const float tot = lf0 + lf1, incl = lane_scan_sum(tot, lane), b0 = incl - tot + lf0, b1 = b0 + lf1;
                const float gsum = __shfl(incl, 63);
                const float w0 = gsum - b0 + li0, w1 = gsum - b1 + li1, mx = wave_max(fmaxf(w0, w1));
                ev[gd * CH + t0] = __expf(w0 - mx); ev[gd * CH + t1] = __expf(w1 - mx);
                if (lane == 0) { GC[itg] = gsum; MC[itg] = mx; }
            }
            __syncthreads();
#pragma unroll
            for (int j = 0; j < 2; ++j) { const int e = tid + NTHR * j, tr = e & 127, c8 = e >> 7; float f[8]; ld8(Z + (size_t)(r0 + tr) * NZ + Z_K + h * DK + c8 * 8, f);
                const float e0 = ev[tr], e1 = ev[CH + tr]; LAS bf16* kp = KeT + (c8 * 8) * VP + tr;
#pragma unroll
                for (int i = 0; i < 8; ++i) { kp[i * VP] = (bf16)f2bf(f[i] * e0); kp[(DK + i) * VP] = (bf16)f2bf(f[i] * e1); } }
            __syncthreads();
            const int it = ((d * BATCH + b) * NH + h) * NC + c;
            f32x16 acc[2];
#pragma unroll
            for (int nt = 0; nt < 2; ++nt)
#pragma unroll
                for (int i = 0; i < 16; ++i) acc[nt][i] = 0.f;
#pragma unroll
            for (int ks = 0; ks < 8; ++ks) { const LAS bf16* ap = VTs + (32 * dvb + l31) * VP + 16 * ks + 8 * hh;
                const v2u a0 = *(const LAS v2u*)ap, a1 = *(const LAS v2u*)(ap + 4); v4u aw; aw.x = a0.x; aw.y = a0.y; aw.z = a1.x; aw.w = a1.y;
#pragma unroll
                for (int nt = 0; nt < 2; ++nt) { const LAS bf16* bp = KeT + (d * DK + 32 * nt + l31) * VP + 16 * ks + 8 * hh;
                    const v2u b0 = *(const LAS v2u*)bp, b1 = *(const LAS v2u*)(bp + 4); v4u bw; bw.x = b0.x; bw.y = b0.y; bw.z = b1.x; bw.w = b1.y;
                    acc[nt] = MFMA32(__builtin_bit_cast(bf16x8, aw), __builtin_bit_cast(bf16x8, bw), acc[nt]); } }
#pragma unroll
            for (int nt = 0; nt < 2; ++nt)
#pragma unroll
                for (int i = 0; i < 16; ++i) CC[(size_t)it * (DV * DK) + (32 * dvb + (i & 3) + 8 * (i >> 2) + 4 * hh) * DK + 32 * nt + l31] = acc[nt][i];
            if (tid < 2 * DK) { const int nd = tid >> 6, ndk = tid & 63; const LAS bf16* kp = KeT + (nd * DK + ndk) * VP; float n = 0.f;
#pragma unroll
                for (int i = 0; i < 32; ++i) { const v2u w = *(const LAS v2u*)(kp + 4 * i); n += (bflo(w.x) + bfhi(w.x)) + (bflo(w.y) + bfhi(w.y)); }
                NCc[(((nd * BATCH + b) * NH + h) * NC + c) * DK + ndk] = n; }
        }
        }
        const float* cw = args.in[8]; const float* cb = args.in[9];
        for (int rb = blockIdx.x; rb < M / 64; rb += G) {
            const int c0 = (tid & 63) * 8, rsub = tid >> 6;
            float w0[8], w1[8], w2[8], bb[8];
#pragma unroll
            for (int i = 0; i < 8; ++i) { w0[i] = cw[c0 + i]; w1[i] = cw[512 + c0 + i]; w2[i] = cw[1024 + c0 + i]; bb[i] = cb[c0 + i]; }
            for (int p = 0; p < 8; ++p) {
                const int row = rb * 64 + p * 8 + rsub, t = row & (SEQ - 1);
                float a[8], bq[8], um[8], u0[8], up[8], bg[8];
                ld8(Z + (size_t)row * NZ + Z_CG + c0, a); ld8(Z + (size_t)row * NZ + Z_HC + c0, bq);
#pragma unroll
                for (int i = 0; i < 8; ++i) u0[i] = a[i] * bq[i];
                if (t > 0) { ld8(Z + (size_t)(row - 1) * NZ + Z_CG + c0, a); ld8(Z + (size_t)(row - 1) * NZ + Z_HC + c0, bq);
#pragma unroll
                    for (int i = 0; i < 8; ++i) um[i] = a[i] * bq[i]; }
                else {
#pragma unroll
                    for (int i = 0; i < 8; ++i) um[i] = 0.f; }
                if (t < SEQ - 1) { ld8(Z + (size_t)(row + 1) * NZ + Z_CG + c0, a); ld8(Z + (size_t)(row + 1) * NZ + Z_HC + c0, bq);
#pragma unroll
                    for (int i = 0; i < 8; ++i) up[i] = a[i] * bq[i]; }
                else {
#pragma unroll
                    for (int i = 0; i < 8; ++i) up[i] = 0.f; }
                ld8(Z + (size_t)row * NZ + Z_BG + c0, bg);
                float y[8];
#pragma unroll
                for (int i = 0; i < 8; ++i) y[i] = bg[i] * (w0[i] * um[i] + w1[i] * u0[i] + w2[i] * up[i] + bb[i]);
                v4u o; o.x = pk2(y[0], y[1]); o.y = pk2(y[2], y[3]); o.z = pk2(y[4], y[5]); o.w = pk2(y[6], y[7]);
                *(v4u*)(Y + (size_t)row * D + c0) = o;
            }
        }
    }
    SEAM(5);
    if (IN(6)) {
        LAS float* sa = (LAS float*)lds; LAS float* ss = sa + 128;
        for (int unit = blockIdx.x; unit < 256; unit += G) {
            const int seq = unit >> 3, part = unit & 7, dir = seq >> 4;
            const int e0 = part * 1024 + 2 * tid;
            const bool nthr = (part == 0 && tid < DK);
            __syncthreads();
            if (tid < NC) { const int it = seq * NC + (dir ? NC - 1 - tid : tid); sa[64 + tid] = GC[it]; ss[64 + tid] = MC[it]; }
            float2 cc[NC]; float ncv[NC];
#pragma unroll
            for (int ci = 0; ci < NC; ++ci) { const int it = seq * NC + (dir ? NC - 1 - ci : ci); cc[ci] = *(const float2*)(CC + (size_t)it * (DV * DK) + e0); ncv[ci] = nthr ? NCc[it * DK + tid] : 0.f; }
            __syncthreads();
            if (tid == 0) { float m = NEG_INF;
                for (int ci = 0; ci < NC; ++ci) { const int it = seq * NC + (dir ? NC - 1 - ci : ci);
                    if (part == 0) MP[it] = m;
                    const float gcv = sa[64 + ci], mcv = ss[64 + ci], mn = fmaxf(gcv + m, mcv);
                    sa[ci] = __expf(gcv + m - mn); ss[ci] = __expf(mcv - mn); m = mn; } }
            __syncthreads();
            float c0 = 0.f, c1 = 0.f, n = 0.f;
#pragma unroll
            for (int ci = 0; ci < NC; ++ci) { const int it = seq * NC + (dir ? NC - 1 - ci : ci);
                *(unsigned*)(CP + (size_t)it * (DV * DK) + e0) = pk2(c0, c1);
                const float a = sa[ci], sc = ss[ci];
                c0 = a * c0 + sc * cc[ci].x; c1 = a * c1 + sc * cc[ci].y;
                if (nthr) { NPp[it * DK + tid] = n; n = a * n + sc * ncv[ci]; } }
        }
    }
    SEAM(6);
    for (int rep7 = 0; rep7 < REP_7; ++rep7)
    if (IN(7)) {
        constexpr int QP = 72, VP = 132, HP = 132;
        LAS bf16* Qs = (LAS bf16*)lds; LAS bf16* Ks = Qs + CH * QP; LAS bf16* VTs = Ks + CH * QP;
        LAS float* gv = (LAS float*)(VTs + DV * VP);
        LAS float* HB = gv + 2 * 6 * CH;
        const float* hgain = args.in[12];
        const int l31 = lane & 31, hh = lane >> 5, d = wave >> 2, rb = wave & 3;
        for (int it2 = blockIdx.x; it2 < BATCH * NH * NC; it2 += G) {
            const int b = it2 >> 7, h = (it2 >> 5) & 3, c = it2 & 31, r0 = b * SEQ + c * CH;
            __syncthreads();
#pragma unroll
            for (int j = 0; j < 2; ++j) { const int e = tid + NTHR * j, row = e >> 3, c8 = e & 7;
                const v4u wq = *(const v4u*)(Z + (size_t)(r0 + row) * NZ + Z_Q + h * DK + c8 * 8); v4u o;
                o.x = pk2(bflo(wq.x) * 0.125f, bfhi(wq.x) * 0.125f); o.y = pk2(bflo(wq.y) * 0.125f, bfhi(wq.y) * 0.125f); o.z = pk2(bflo(wq.z) * 0.125f, bfhi(wq.z) * 0.125f); o.w = pk2(bflo(wq.w) * 0.125f, bfhi(wq.w) * 0.125f);
                *(LAS v4u*)(Qs + row * QP + c8 * 8) = o;
                *(LAS v4u*)(Ks + row * QP + c8 * 8) = *(const v4u*)(Z + (size_t)(r0 + row) * NZ + Z_K + h * DK + c8 * 8); }
#pragma unroll
            for (int j = 0; j < 4; ++j) { const int e = tid + NTHR * j, sr = e & 127, c16 = e >> 7;
                const v4u w = *(const v4u*)(Z + (size_t)(r0 + sr) * NZ + Z_V + h * DV + c16 * 8); LAS bf16* vp = VTs + (c16 * 8) * VP + sr;
                vp[0 * VP] = (bf16)(w.x & 0xffffu); vp[1 * VP] = (bf16)(w.x >> 16); vp[2 * VP] = (bf16)(w.y & 0xffffu); vp[3 * VP] = (bf16)(w.y >> 16);
                vp[4 * VP] = (bf16)(w.z & 0xffffu); vp[5 * VP] = (bf16)(w.z >> 16); vp[6 * VP] = (bf16)(w.w & 0xffffu); vp[7 * VP] = (bf16)(w.w >> 16); }
            if (wave < 2) {
                const int gd = wave, itg = ((gd * BATCH + b) * NH + h) * NC + c;
                const int t0 = gd ? 127 - 2 * lane : 2 * lane, t1 = gd ? 126 - 2 * lane : 2 * lane + 1;
                const float lf0 = Gt[(size_t)(r0 + t0) * 16 + 8 + gd * 4 + h], lf1 = Gt[(size_t)(r0 + t1) * 16 + 8 + gd * 4 + h];
                const float li0 = Gt[(size_t)(r0 + t0) * 16 + gd * 4 + h], li1 = Gt[(size_t)(r0 + t1) * 16 + gd * 4 + h];
                const float mprev = MP[itg];
                const float tot = lf0 + lf1, incl = lane_scan_sum(tot, lane), b0 = incl - tot + lf0, b1 = b0 + lf1;
                const float be0 = li0 - b0, be1 = li1 - b1, mloc = fmaxf(be0, be1), minc = lane_scan_max(mloc, lane);
                float mex = __shfl_up(minc, 1); if (lane == 0) mex = -3.0e38f;
                const float c0 = fmaxf(mex, be0), c1 = fmaxf(c0, be1);
                const float mt0 = fmaxf(b0 + mprev, b0 + c0), mt1 = fmaxf(b1 + mprev, b1 + c1);
                LAS float* g6 = gv + gd * 6 * CH;
                g6[1 * CH + t0] = be0; g6[1 * CH + t1] = be1;
                g6[2 * CH + t0] = b0 - mt0; g6[2 * CH + t1] = b1 - mt1;
                g6[3 * CH + t0] = __expf(b0 + mprev - mt0); g6[3 * CH + t1] = __expf(b1 + mprev - mt1);
                g6[4 * CH + t0] = __expf(-mt0); g6[4 * CH + t1] = __expf(-mt1);
            }
            __syncthreads();
            const int it = ((d * BATCH + b) * NH + h) * NC + c;
            const LAS float* gvd = gv + d * 6 * CH;
            bf16x8 qf[4];
#pragma unroll
            for (int kk = 0; kk < 4; ++kk) qf[kk] = *(const LAS bf16x8*)(Qs + (32 * rb + l31) * QP + 16 * kk + 8 * hh);
            f32x16 acc[4];
#pragma unroll
            for (int nt = 0; nt < 4; ++nt) {
#pragma unroll
                for (int i = 0; i < 16; ++i) acc[nt][i] = 0.f;
#pragma unroll
                for (int kk = 0; kk < 4; ++kk) { const bf16x8 cb = *(const bf16x8*)(CP + (size_t)it * (DV * DK) + (32 * nt + l31) * DK + 16 * kk + 8 * hh); acc[nt] = MFMA32(qf[kk], cb, acc[nt]); } }
#pragma unroll
            for (int g = 0; g < 4; ++g) { const f32x4 iv = *(const LAS f32x4*)(gvd + 3 * CH + 32 * rb + 8 * g + 4 * hh);
#pragma unroll
                for (int nt = 0; nt < 4; ++nt)
#pragma unroll
                    for (int i = 0; i < 4; ++i) acc[nt][4 * g + i] *= iv[i]; }
            const float alpha_t = gvd[2 * CH + 32 * rb + l31]; float rowsum = 0.f;
#pragma unroll 1
            for (int sb = 0; sb < 4; ++sb) {
                if (d == 0 ? (sb > rb) : (sb < rb)) continue;
                f32x16 xx;
#pragma unroll
                for (int i = 0; i < 16; ++i) xx[i] = 0.f;
#pragma unroll
                for (int kk = 0; kk < 4; ++kk) { const bf16x8 kf = *(const LAS bf16x8*)(Ks + (32 * sb + l31) * QP + 16 * kk + 8 * hh); xx = MFMA32(kf, qf[kk], xx); }
                const int tl = 32 * rb + l31;
#pragma unroll
                for (int g = 0; g < 4; ++g) { const f32x4 bv = *(const LAS f32x4*)(gvd + 1 * CH + 32 * sb + 8 * g + 4 * hh);
#pragma unroll
                    for (int i = 0; i < 4; ++i) { const int sl = 32 * sb + 8 * g + 4 * hh + i; const bool valid = d == 0 ? (sl <= tl) : (sl >= tl);
                        const float p = valid ? __expf(alpha_t + bv[i]) * xx[4 * g + i] : 0.f; xx[4 * g + i] = p; rowsum += p; } }
#pragma unroll
                for (int ks = 0; ks < 2; ++ks) {
                    v4u pw; pw.x = cvtpk(xx[8 * ks + 0], xx[8 * ks + 1]); pw.y = cvtpk(xx[8 * ks + 2], xx[8 * ks + 3]); pw.z = cvtpk(xx[8 * ks + 4], xx[8 * ks + 5]); pw.w = cvtpk(xx[8 * ks + 6], xx[8 * ks + 7]);
                    const bf16x8 pa = __builtin_bit_cast(bf16x8, pw);
#pragma unroll
                    for (int nt = 0; nt < 4; ++nt) { const LAS bf16* vp = VTs + (32 * nt + l31) * VP + 32 * sb + 16 * ks + 4 * hh;
                        const v2u lo = *(const LAS v2u*)vp, hi2 = *(const LAS v2u*)(vp + 8); v4u vw; vw.x = lo.x; vw.y = lo.y; vw.z = hi2.x; vw.w = hi2.y;
                        acc[nt] = MFMA32(pa, __builtin_bit_cast(bf16x8, vw), acc[nt]); } }
            }
            rowsum += __shfl_xor(rowsum, 32);
            float qn = 0.f;
#pragma unroll
            for (int i = 0; i < 32; ++i) qn += bf2f(Qs[(32 * rb + l31) * QP + 32 * hh + i]) * NPp[it * DK + 32 * hh + i];
            qn += __shfl_xor(qn, 32);
            { const float denom = gvd[3 * CH + 32 * rb + l31] * qn + rowsum; gv[(d * 6 + 5) * CH + 32 * rb + l31] = 1.0f / fmaxf(fabsf(denom), gvd[4 * CH + 32 * rb + l31]); }
            LDS_WAIT();
#pragma unroll
            for (int g = 0; g < 4; ++g) { const f32x4 dv4 = *(const LAS f32x4*)(gvd + 5 * CH + 32 * rb + 8 * g + 4 * hh);
#pragma unroll
                for (int nt = 0; nt < 4; ++nt)
#pragma unroll
                    for (int i = 0; i < 4; ++i) acc[nt][4 * g + i] *= dv4[i]; }
            if (d == 1) {
#pragma unroll
                for (int nt = 0; nt < 4; ++nt)
#pragma unroll
                    for (int i = 0; i < 16; ++i) HB[(32 * rb + (i & 3) + 8 * (i >> 2) + 4 * hh) * HP + 32 * nt + l31] = acc[nt][i]; }
            __syncthreads();
            if (d == 0) {
#pragma unroll
                for (int nt = 0; nt < 4; ++nt)
#pragma unroll
                    for (int i = 0; i < 16; ++i) HB[(32 * rb + (i & 3) + 8 * (i >> 2) + 4 * hh) * HP + 32 * nt + l31] += acc[nt][i]; }
            __syncthreads();
            { const int t = tid >> 2, dvq = tid & 3; f32x4 hv[8]; float sq = 0.f;
#pragma unroll
                for (int j = 0; j < 8; ++j) { hv[j] = *(const LAS f32x4*)(HB + t * HP + dvq * 32 + 4 * j); sq += (hv[j].x * hv[j].x + hv[j].y * hv[j].y) + (hv[j].z * hv[j].z + hv[j].w * hv[j].w); }
                sq += __shfl_xor(sq, 1); sq += __shfl_xor(sq, 2);
                const float r = 1.0f / sqrtf(sq * (1.f / DV) + EPS);
#pragma unroll
                for (int j8 = 0; j8 < 4; ++j8) { float o[8]; ld8(Z + (size_t)(r0 + t) * NZ + Z_O + h * DV + dvq * 32 + j8 * 8, o);
                    const f32x4 g0 = *(const f32x4*)(hgain + h * DV + dvq * 32 + j8 * 8), g1 = *(const f32x4*)(hgain + h * DV + dvq * 32 + j8 * 8 + 4);
                    const f32x4 a0 = hv[2 * j8], a1 = hv[2 * j8 + 1]; float y[8];
#pragma unroll
                    for (int i = 0; i < 4; ++i) { y[i] = a0[i] * r * g0[i] / (1.0f + __expf(-o[i])); y[4 + i] = a1[i] * r * g1[i] / (1.0f + __expf(-o[4 + i])); }
                    v4u w; w.x = pk2(y[0], y[1]); w.y = pk2(y[2], y[3]); w.z = pk2(y[4], y[5]); w.w = pk2(y[6], y[7]);
                    *(v4u*)(Y + (size_t)(r0 + t) * D + 512 + h * DV + dvq * 32 + j8 * 8) = w; } }
        }
    }
    SEAM(7);
    }
    if (IN(8)) {
        pg8::Gemm g{Y, WMO, M, D, D}; pg8::StaticOrder S; S.init(M, D, G, (int)blockIdx.x);
        pg8::EpiBf16 E{H, D};
        pg8::gemm_phase<pg8::EpiBf16, pg8::StaticOrder, true, true>(lds, g, S, E);
    }
    SEAM(8);
    if (IN(9)) norm_rows<true, true>(out, H, args.in[6], 1.0f, out, args.in[14], XN, gw, NGW, lane);
    SEAM(9);
    if (IN(10)) {
        pg8::Gemm g{XN, W2I, M, 2 * FF, D}; pg8::StaticOrder S; S.init(M, 2 * FF, G, (int)blockIdx.x);
        pg8::EpiSwiglu E{ACT, FF};
        pg8::gemm_phase<pg8::EpiSwiglu, pg8::StaticOrder, true, true>(lds, g, S, E);
    }
    SEAM(10);
    if (IN(11)) {
        pg8::Gemm g{ACT, W2O, M, D, FF}; pg8::StaticOrder S; S.init(M, D, G, (int)blockIdx.x);
        pg8::EpiBf16 E{H, D};
        pg8::gemm_phase<pg8::EpiBf16, pg8::StaticOrder, true, true>(lds, g, S, E);
    }
    SEAM(11);
    if (IN(12)) norm_rows<true, false>(out, H, args.in[15], 0.5f, out, nullptr, nullptr, gw, NGW, lane);
#undef IN
#undef SEAM
}

extern "C" void kernel_launch(void* const* d_in, const int* in_sizes, int n_in, void* d_out, int out_size, void* d_ws, size_t ws_size, hipStream_t stream) {
    static int grid = 0;
    if (grid == 0) {
        if (n_in != 18 || in_sizes[0] != M * D || out_size != M * D || ws_size < WS_END) { fprintf(stderr, "kernel_launch: unexpected shapes (n_in %d, in0 %d, out %d, ws %zu)\n", n_in, n_in > 0 ? in_sizes[0] : -1, out_size, ws_size); grid = -1; return; }
        int dev = 0, cus = 0, per_cu = 0;
        if (hipGetDevice(&dev) != hipSuccess || hipDeviceGetAttribute(&cus, hipDeviceAttributeMultiprocessorCount, dev) != hipSuccess) { grid = -1; return; }
        if (hipFuncSetAttribute((const void*)fwd, hipFuncAttributeMaxDynamicSharedMemorySize, LDS_BYTES) != hipSuccess) { fprintf(stderr, "kernel_launch: hipFuncSetAttribute failed\n"); grid = -1; return; }
        if (hipOccupancyMaxActiveBlocksPerMultiprocessor(&per_cu, (const void*)fwd, NTHR, LDS_BYTES) != hipSuccess || per_cu < 1) { fprintf(stderr, "kernel_launch: occupancy query says %d blocks per CU\n", per_cu); grid = -1; return; }
        grid = cus;
    }
    if (grid < 0) return;
    if (hipMemsetAsync(d_ws, 0, 65536, stream) != hipSuccess) { fprintf(stderr, "kernel_launch: memset of the barrier words failed\n"); return; }
    Args a{};
    for (int i = 0; i < 18; ++i) a.in[i] = (const float*)d_in[i];
    a.out = (float*)d_out; a.ws = (unsigned char*)d_ws;
    const int cuts[] = MK_CUTS;
    const int ncuts = (int)(sizeof(cuts) / sizeof(cuts[0]));
    for (int li = 0; li + 1 < ncuts; ++li) {
        a.ph_lo = cuts[li]; a.ph_hi = cuts[li + 1];
        void* kargs[] = {&a};
        const hipError_t le = hipLaunchCooperativeKernel((const void*)fwd, dim3(grid), dim3(NTHR), kargs, LDS_BYTES, stream);
        if (le != hipSuccess) { fprintf(stderr, "kernel_launch: cooperative launch %d failed: %s (grid %d)\n", li, hipGetErrorString(le), grid); break; }
    }
}
```
